# Optimizing an MI355X kernel written in HIP

```python
import jax, jax.numpy as jnp
from jax import lax
import numpy as np

D_MODEL = 1024
BATCH = 8
SEQ = 4096
DEPTH = 2

N_A_LAYERS = DEPTH // 2
N_B_LAYERS = DEPTH - N_A_LAYERS
HEAD_DIM = 64
N_HEADS = D_MODEL // HEAD_DIM
ATTN_DIM = N_HEADS * HEAD_DIM
FOX_Q_BLOCK = 128
NSA_KV_GROUPS = 4
NSA_HEADS_PER_GROUP = N_HEADS // NSA_KV_GROUPS
NSA_KV_DIM = NSA_KV_GROUPS * HEAD_DIM
NSA_N_KV = 6
CMP_BLOCK = 32
CMP_STRIDE = 16
CMP_HIDDEN = 128
SLC_BLOCK = 64
SLC_TOPK = 16
WINDOW = 512
NSA_Q_BLOCK = 32
N_EXPERTS = 256
EXPERT_TOPK = 8
EXPERT_GROUPS = 8
EXPERT_TOPK_GROUPS = 4
EXPERT_HIDDEN = 256
ROUTED_SCALE = 2.5
MOE_ROW_BLOCK = 128
PLE_DIM = 256
LN_EPS = 1e-5
DEEPNORM_ALPHA = (2.0 * DEPTH) ** 0.25
DEEPNORM_BETA = (8.0 * DEPTH) ** -0.25
NEG_INF = -1e30
FORCE_SELECT = 1e9

kernel_name = "hybrid_fox_nsa_deepseekmoe_deepnorm"


def layer_norm(x, g, b):
    xf = x.astype(jnp.float32)
    mu = jnp.mean(xf, axis=-1, keepdims=True)
    var = jnp.mean(jnp.square(xf - mu), axis=-1, keepdims=True)
    return ((xf - mu) * lax.rsqrt(var + LN_EPS) * g + b).astype(x.dtype)


def masked_softmax(s, mask):
    s = jnp.where(mask, s, NEG_INF)
    return jnp.where(mask, jax.nn.softmax(s, axis=-1), 0.0)


def alibi_slopes():
    return jnp.asarray(2.0 ** (-8.0 * np.arange(1, N_HEADS + 1) / N_HEADS), jnp.float32)


def compressed_to_selection_weights(n_cmp, n_slc):
    cs = np.arange(n_cmp)[:, None] * CMP_STRIDE
    ce = cs + CMP_BLOCK
    ss = np.arange(n_slc)[None, :] * SLC_BLOCK
    se = ss + SLC_BLOCK
    w = np.clip(np.minimum(ce, se) - np.maximum(cs, ss), 0, None) / CMP_STRIDE
    return jnp.asarray(w, jnp.float32)


def forgetting_attention(x, w_in, b_f, w_out):
    B, S, _ = x.shape
    proj = x @ w_in
    q, k, v = [proj[..., i * ATTN_DIM:(i + 1) * ATTN_DIM].reshape(B, S, N_HEADS, HEAD_DIM)
               for i in range(3)]
    log_f = jax.nn.log_sigmoid((proj[..., 3 * ATTN_DIM:] + b_f).astype(jnp.float32))
    c = jnp.cumsum(log_f, axis=1).transpose(0, 2, 1)
    scale = HEAD_DIM ** -0.5
    k_pos = jnp.arange(S)

    def block(i):
        q0 = i * FOX_Q_BLOCK
        qb = lax.dynamic_slice_in_dim(q, q0, FOX_Q_BLOCK, axis=1)
        cb = lax.dynamic_slice_in_dim(c, q0, FOX_Q_BLOCK, axis=2)
        t = q0 + jnp.arange(FOX_Q_BLOCK)
        s = jnp.einsum('bqhd,bshd->bhqs', qb, k, preferred_element_type=jnp.float32) * scale
        s = s + cb[..., :, None] - c[..., None, :]
        p = masked_softmax(s, k_pos[None, :] <= t[:, None])
        return jnp.einsum('bhqs,bshd->bqhd', p.astype(v.dtype), v)

    o = lax.map(block, jnp.arange(S // FOX_Q_BLOCK))
    o = o.transpose(1, 0, 2, 3, 4).reshape(B, S, ATTN_DIM)
    return o @ w_out


def nsa_shared_kv(x, w_kv, cmp_pe, cmp_w1, cmp_b1, cmp_w2):
    B, S, _ = x.shape
    kv = (x @ w_kv).reshape(B, S, NSA_N_KV, NSA_KV_GROUPS, HEAD_DIM)
    k_cr, v_cr, k_sl, v_sl, k_wn, v_wn = [kv[:, :, i] for i in range(NSA_N_KV)]
    n_cmp = (S - CMP_BLOCK) // CMP_STRIDE + 1
    idx = np.arange(n_cmp)[:, None] * CMP_STRIDE + np.arange(CMP_BLOCK)[None, :]

    def compress(raw, j):
        blk = raw[:, idx] + cmp_pe[j][None, None, :, None, :]
        blk = blk.transpose(0, 1, 3, 2, 4).reshape(B, n_cmp, NSA_KV_GROUPS, CMP_BLOCK * HEAD_DIM)
        h = jax.nn.gelu(blk @ cmp_w1[j] + cmp_b1[j])
        return h @ cmp_w2[j]

    k_cmp = compress(k_cr, 0)
    v_cmp = compress(v_cr, 1)
    n_slc = S // SLC_BLOCK
    k_slc = k_sl.reshape(B, n_slc, SLC_BLOCK, NSA_KV_GROUPS, HEAD_DIM).transpose(0, 3, 1, 2, 4)
    v_slc = v_sl.reshape(B, n_slc, SLC_BLOCK, NSA_KV_GROUPS, HEAD_DIM).transpose(0, 3, 1, 2, 4)
    pad = ((0, 0), (WINDOW, 0), (0, 0), (0, 0))
    k_win = jnp.pad(k_wn, pad)
    v_win = jnp.pad(v_wn, pad)
    return (k_cmp, v_cmp, k_slc, v_slc, k_win, v_win)


def native_sparse_attention(x, shared_kv, w_q, b_g, w_out):
    k_cmp, v_cmp, k_slc, v_slc, k_win, v_win = shared_kv
    B, S, _ = x.shape
    G, R, dh = NSA_KV_GROUPS, NSA_HEADS_PER_GROUP, HEAD_DIM
    dt = x.dtype
    proj = x @ w_q
    q = proj[..., :ATTN_DIM].reshape(B, S, G, R, dh)
    gates = jax.nn.sigmoid((proj[..., ATTN_DIM:] + b_g).astype(jnp.float32)).reshape(B, S, G, R, 3)
    slopes = alibi_slopes().reshape(G, R)
    n_cmp = k_cmp.shape[1]
    n_slc = k_slc.shape[2]
    topk = min(SLC_TOPK, n_slc)
    cmp_end = jnp.arange(n_cmp) * CMP_STRIDE + CMP_BLOCK - 1
    cmp_to_slc = compressed_to_selection_weights(n_cmp, n_slc)
    blk_ids = jnp.arange(n_slc)
    b_ix = jnp.arange(B)[:, None, None, None]
    g_ix = jnp.arange(G)[None, :, None, None]
    scale = dh ** -0.5

    def block(i):
        q0 = i * NSA_Q_BLOCK
        qb = lax.dynamic_slice_in_dim(q, q0, NSA_Q_BLOCK, axis=1)
        gb = lax.dynamic_slice_in_dim(gates, q0, NSA_Q_BLOCK, axis=1)
        t = q0 + jnp.arange(NSA_Q_BLOCK)
        dist_c = (t[:, None] - cmp_end[None, :]).astype(jnp.float32)
        s_c = jnp.einsum('bqgrd,bcgd->bgrqc', qb, k_cmp, preferred_element_type=jnp.float32) * scale
        s_c = s_c - slopes[:, :, None, None] * dist_c
        p_c = masked_softmax(s_c, dist_c >= 0)
        o_c = jnp.einsum('bgrqc,bcgd->bqgrd', p_c.astype(dt), v_cmp)
        imp = jnp.einsum('bgrqc,cj->bgqj', p_c, cmp_to_slc)
        cur = t // SLC_BLOCK
        visible = blk_ids[None, :] * SLC_BLOCK <= t[:, None]
        forced = ((blk_ids[None, :] == 0) | (blk_ids[None, :] == cur[:, None])
                  | (blk_ids[None, :] == cur[:, None] - 1))
        sel_score = jnp.where(forced, FORCE_SELECT, jnp.where(visible, imp, NEG_INF))
        sel_val, sel_idx = lax.top_k(sel_score, topk)
        valid = sel_val > 0.5 * NEG_INF
        k_sel = k_slc[b_ix, g_ix, sel_idx].reshape(B, G, NSA_Q_BLOCK, topk * SLC_BLOCK, dh)
        v_sel = v_slc[b_ix, g_ix, sel_idx].reshape(B, G, NSA_Q_BLOCK, topk * SLC_BLOCK, dh)
        s_pos = (sel_idx[..., None] * SLC_BLOCK + jnp.arange(SLC_BLOCK)).reshape(
            B, G, NSA_Q_BLOCK, topk * SLC_BLOCK)
        dist_s = (t[None, None, :, None] - s_pos).astype(jnp.float32)
        mask_s = jnp.repeat(valid, SLC_BLOCK, axis=-1) & (dist_s >= 0)
        s_s = jnp.einsum('bqgrd,bgqnd->bgrqn', qb, k_sel, preferred_element_type=jnp.float32) * scale
        s_s = s_s - slopes[None, :, :, None, None] * dist_s[:, :, None]
        p_s = masked_softmax(s_s, mask_s[:, :, None])
        o_s = jnp.einsum('bgrqn,bgqnd->bqgrd', p_s.astype(dt), v_sel)
        kw = lax.dynamic_slice_in_dim(k_win, q0, NSA_Q_BLOCK + WINDOW, axis=1)
        vw = lax.dynamic_slice_in_dim(v_win, q0, NSA_Q_BLOCK + WINDOW, axis=1)
        w_pos = q0 - WINDOW + jnp.arange(NSA_Q_BLOCK + WINDOW)
        dist_w = t[:, None] - w_pos[None, :]
        mask_w = (w_pos[None, :] >= 0) & (dist_w >= 0) & (dist_w < WINDOW)
        s_w = jnp.einsum('bqgrd,bsgd->bgrqs', qb, kw, preferred_element_type=jnp.float32) * scale
        s_w = s_w - slopes[:, :, None, None] * dist_w.astype(jnp.float32)
        p_w = masked_softmax(s_w, mask_w)
        o_w = jnp.einsum('bgrqs,bsgd->bqgrd', p_w.astype(dt), vw)
        o = gb[..., 0:1] * o_c + gb[..., 1:2] * o_s + gb[..., 2:3] * o_w
        return o.reshape(B, NSA_Q_BLOCK, ATTN_DIM).astype(dt)

    o = lax.map(block, jnp.arange(S // NSA_Q_BLOCK))
    o = o.transpose(1, 0, 2, 3).reshape(B, S, ATTN_DIM)
    return o @ w_out


def swiglu(x, w_gate, w_up, w_down):
    return (jax.nn.silu(x @ w_gate) * (x @ w_up)) @ w_down


def routed_experts(xt, idx, w, w_gate, w_up, w_down):
    N, D = xt.shape
    A = N * EXPERT_TOPK
    e_flat = idx.reshape(A)
    tok_flat = jnp.repeat(jnp.arange(N, dtype=jnp.int32), EXPERT_TOPK)
    w_flat = w.reshape(A)
    order = jnp.argsort(e_flat)
    e_sorted = e_flat[order]
    counts = jnp.bincount(e_flat, length=N_EXPERTS)
    padded = (counts + MOE_ROW_BLOCK - 1) // MOE_ROW_BLOCK * MOE_ROW_BLOCK
    start = jnp.cumsum(counts) - counts
    pad_end = jnp.cumsum(padded)
    pad_start = pad_end - padded
    dest = pad_start[e_sorted] + jnp.arange(A) - start[e_sorted]
    n_blocks = -(-(A + N_EXPERTS * (MOE_ROW_BLOCK - 1)) // MOE_ROW_BLOCK)
    n_rows = n_blocks * MOE_ROW_BLOCK
    tok_pad = jnp.zeros((n_rows,), jnp.int32).at[dest].set(tok_flat[order])
    w_pad = jnp.zeros((n_rows,), jnp.float32).at[dest].set(w_flat[order])
    blk_expert = jnp.minimum(
        jnp.searchsorted(pad_end, jnp.arange(n_blocks) * MOE_ROW_BLOCK, side='right'), N_EXPERTS - 1)

    def step(acc, b):
        toks = lax.dynamic_slice_in_dim(tok_pad, b * MOE_ROW_BLOCK, MOE_ROW_BLOCK)
        wb = lax.dynamic_slice_in_dim(w_pad, b * MOE_ROW_BLOCK, MOE_ROW_BLOCK)
        e = blk_expert[b]
        y = swiglu(xt[toks], w_gate[e], w_up[e], w_down[e]).astype(jnp.float32) * wb[:, None]
        return acc.at[toks].add(y), None

    acc, _ = lax.scan(step, jnp.zeros((N, D), jnp.float32), jnp.arange(n_blocks))
    return acc.astype(xt.dtype)


def moe_ffn(x, w_router, b_router, w_gate, w_up, w_down, sh_gate, sh_up, sh_down):
    B, S, D = x.shape
    xt = x.reshape(B * S, D)
    N = xt.shape[0]
    scores = jax.nn.sigmoid((xt @ w_router).astype(jnp.float32))
    biased = scores + b_router.astype(jnp.float32)
    grp = biased.reshape(N, EXPERT_GROUPS, N_EXPERTS // EXPERT_GROUPS)
    grp_score = jnp.sum(lax.top_k(grp, 2)[0], axis=-1)
    _, grp_idx = lax.top_k(grp_score, EXPERT_TOPK_GROUPS)
    grp_mask = jnp.sum(jax.nn.one_hot(grp_idx, EXPERT_GROUPS), axis=-2) > 0
    cand = jnp.where(grp_mask[:, :, None], grp, NEG_INF).reshape(N, N_EXPERTS)
    _, idx = lax.top_k(cand, EXPERT_TOPK)
    s_sel = jnp.take_along_axis(scores, idx, axis=-1)
    w = s_sel / jnp.sum(s_sel, axis=-1, keepdims=True) * ROUTED_SCALE
    routed = routed_experts(xt, idx, w, w_gate, w_up, w_down)
    shared = swiglu(xt, sh_gate, sh_up, sh_down)
    return (routed + shared).reshape(B, S, D)


def per_layer_embedding(x, p_i, w_proj, w_gate, b_gate):
    return jax.nn.sigmoid(x @ w_gate + b_gate) * (p_i @ w_proj)


def setup_inputs(seed: int = 0) -> dict:
    key = jax.random.key(seed)
    ks = jax.random.split(key, 26)

    def nrm(k, shape, scale):
        return jax.random.normal(k, shape, jnp.float32) * scale

    fox_cols = jnp.concatenate([jnp.ones((2 * ATTN_DIM,), jnp.float32),
                                jnp.full((ATTN_DIM,), DEEPNORM_BETA, jnp.float32),
                                jnp.ones((N_HEADS,), jnp.float32)])
    kv_cols = jnp.repeat(jnp.asarray([1.0, DEEPNORM_BETA] * 3, jnp.float32), NSA_KV_DIM)
    return {
        'x': nrm(ks[0], (BATCH, SEQ, D_MODEL), 1.0),
        'p': nrm(ks[1], (DEPTH, BATCH, SEQ, PLE_DIM), 1.0),
        'fox_w_in': nrm(ks[2], (N_A_LAYERS, D_MODEL, 3 * ATTN_DIM + N_HEADS), D_MODEL ** -0.5) * fox_cols,
        'fox_b_f': 2.0 + nrm(ks[3], (N_A_LAYERS, N_HEADS), 0.5),
        'fox_w_out': nrm(ks[4], (N_A_LAYERS, ATTN_DIM, D_MODEL), ATTN_DIM ** -0.5 * DEEPNORM_BETA),
        'nsa_w_kv': nrm(ks[5], (D_MODEL, NSA_N_KV * NSA_KV_DIM), D_MODEL ** -0.5) * kv_cols,
        'cmp_pe': nrm(ks[6], (2, CMP_BLOCK, HEAD_DIM), 0.5),
        'cmp_w1': nrm(ks[7], (2, CMP_BLOCK * HEAD_DIM, CMP_HIDDEN), (CMP_BLOCK * HEAD_DIM) ** -0.5),
        'cmp_b1': nrm(ks[8], (2, CMP_HIDDEN), 0.01),
        'cmp_w2': nrm(ks[9], (2, CMP_HIDDEN, HEAD_DIM), CMP_HIDDEN ** -0.5),
        'nsa_w_q': nrm(ks[10], (N_B_LAYERS, D_MODEL, ATTN_DIM + 3 * N_HEADS), D_MODEL ** -0.5),
        'nsa_b_g': nrm(ks[11], (N_B_LAYERS, 3 * N_HEADS), 0.1),
        'nsa_w_out': nrm(ks[12], (N_B_LAYERS, ATTN_DIM, D_MODEL), ATTN_DIM ** -0.5 * DEEPNORM_BETA),
        'ln_g': 1.0 + nrm(ks[13], (DEPTH, 3, D_MODEL), 0.05),
        'ln_b': nrm(ks[14], (DEPTH, 3, D_MODEL), 0.02),
        'moe_w_router': nrm(ks[15], (DEPTH, D_MODEL, N_EXPERTS), D_MODEL ** -0.5),
        'moe_b_router': nrm(ks[16], (DEPTH, N_EXPERTS), 0.01),
        'moe_w_gate': nrm(ks[17], (DEPTH, N_EXPERTS, D_MODEL, EXPERT_HIDDEN), D_MODEL ** -0.5),
        'moe_w_up': nrm(ks[18], (DEPTH, N_EXPERTS, D_MODEL, EXPERT_HIDDEN), D_MODEL ** -0.5),
        'moe_w_down': nrm(ks[19], (DEPTH, N_EXPERTS, EXPERT_HIDDEN, D_MODEL), EXPERT_HIDDEN ** -0.5 * DEEPNORM_BETA),
        'shared_w_gate': nrm(ks[20], (DEPTH, D_MODEL, EXPERT_HIDDEN), D_MODEL ** -0.5),
        'shared_w_up': nrm(ks[21], (DEPTH, D_MODEL, EXPERT_HIDDEN), D_MODEL ** -0.5),
        'shared_w_down': nrm(ks[22], (DEPTH, EXPERT_HIDDEN, D_MODEL), EXPERT_HIDDEN ** -0.5 * DEEPNORM_BETA),
        'ple_w_proj': nrm(ks[23], (DEPTH, PLE_DIM, D_MODEL), PLE_DIM ** -0.5 * DEEPNORM_BETA),
        'ple_w_gate': nrm(ks[24], (DEPTH, D_MODEL, D_MODEL), D_MODEL ** -0.5),
        'ple_b_gate': nrm(ks[25], (DEPTH, D_MODEL), 0.1),
    }


def reference(x, p, fox_w_in, fox_b_f, fox_w_out, nsa_w_kv, cmp_pe, cmp_w1, cmp_b1, cmp_w2,
              nsa_w_q, nsa_b_g, nsa_w_out, ln_g, ln_b, moe_w_router, moe_b_router,
              moe_w_gate, moe_w_up, moe_w_down, shared_w_gate, shared_w_up, shared_w_down,
              ple_w_proj, ple_w_gate, ple_b_gate):
    shared_kv = None
    for i in range(DEPTH):
        if i < N_A_LAYERS:
            mix = forgetting_attention(x, fox_w_in[i], fox_b_f[i], fox_w_out[i])
        else:
            if i == N_A_LAYERS:
                shared_kv = nsa_shared_kv(x, nsa_w_kv, cmp_pe, cmp_w1, cmp_b1, cmp_w2)
            j = i - N_A_LAYERS
            mix = native_sparse_attention(x, shared_kv, nsa_w_q[j], nsa_b_g[j], nsa_w_out[j])
        x = layer_norm(DEEPNORM_ALPHA * x + mix, ln_g[i, 0], ln_b[i, 0])
        ffn = moe_ffn(x, moe_w_router[i], moe_b_router[i], moe_w_gate[i], moe_w_up[i], moe_w_down[i],
                      shared_w_gate[i], shared_w_up[i], shared_w_down[i])
        x = layer_norm(DEEPNORM_ALPHA * x + ffn, ln_g[i, 1], ln_b[i, 1])
        ple = per_layer_embedding(x, p[i], ple_w_proj[i], ple_w_gate[i], ple_b_gate[i])
        x = layer_norm(DEEPNORM_ALPHA * x + ple, ln_g[i, 2], ln_b[i, 2])
    return x
```

```cpp
#include <hip/hip_runtime.h>
#include <cstdio>
#include <cstdint>

#ifndef MK_PER_PHASE
#define MK_PER_PHASE 0
#endif

#define GAS __attribute__((address_space(1)))
#define LAS __attribute__((address_space(3)))
typedef unsigned short bf16;
typedef unsigned v4u __attribute__((ext_vector_type(4)));
typedef unsigned v2u __attribute__((ext_vector_type(2)));
typedef float f32x2 __attribute__((ext_vector_type(2)));
typedef float f32x4 __attribute__((ext_vector_type(4)));
typedef float f32x16 __attribute__((ext_vector_type(16)));
typedef short bf16x8 __attribute__((ext_vector_type(8)));
typedef short bf16x4 __attribute__((ext_vector_type(4)));
typedef unsigned long long u64;

constexpr int NB = 8, SEQ = 4096, D = 1024, NTOK = NB * SEQ, NH = 16, HD = 64;
constexpr int NE = 256, TOPK = 8, EH = 256, PLE = 256;
constexpr int NWAVES = 8, NTHREADS = NWAVES * 64;
constexpr float LN_EPS = 1e-5f;
constexpr float ALPHA = 1.41421356237309515f;
constexpr float LOG2E = 1.44269504088896341f;
constexpr float QSCALE = 0.125f * LOG2E;
constexpr float NEGBIG = -1e30f;

constexpr size_t MiB = 1u << 20;
constexpr size_t WS_CTL = 0, CTL_ZERO_BYTES = 1 * MiB;
constexpr size_t WS_W_FQK = 1 * MiB;
constexpr size_t WS_W_FV = 5 * MiB;
constexpr size_t WS_W_FO = 7 * MiB;
constexpr size_t WS_W_KVTOK = 9 * MiB;
constexpr size_t WS_W_KVTR = 11 * MiB;
constexpr size_t WS_W_NQ = 12 * MiB;
constexpr size_t WS_W_NO = 14 * MiB;
constexpr size_t WS_W_RT = 16 * MiB;
constexpr size_t WS_W_SGU = 17 * MiB;
constexpr size_t WS_W_SD = 19 * MiB;
constexpr size_t WS_W_PP = 20 * MiB;
constexpr size_t WS_W_PG = 21 * MiB;
constexpr size_t WS_W_C1 = 25 * MiB;
constexpr size_t WS_B1P = 27 * MiB;
constexpr size_t WS_KC = 27 * MiB + 65536;
constexpr size_t WS_VCT = 29 * MiB;
constexpr size_t WS_HMID = 30 * MiB;
constexpr size_t WS_W_EGU = 34 * MiB;
constexpr size_t WS_W_ED = 546 * MiB;
constexpr size_t WS_XB = 802 * MiB;
constexpr size_t WS_XFA = 866 * MiB;
constexpr size_t WS_PB = 994 * MiB;
constexpr size_t WS_PPROJ = 1026 * MiB;
constexpr size_t WS_QK = 1090 * MiB;
constexpr size_t WS_VT = 1218 * MiB;
constexpr size_t WS_H = WS_QK;
constexpr size_t WS_O = 1282 * MiB;
constexpr size_t WS_LOGF = 1346 * MiB;
constexpr size_t WS_C2 = 1348 * MiB;
constexpr size_t WS_GATES = 1350 * MiB;
constexpr size_t WS_SCORES = 1356 * MiB;
constexpr size_t WS_WTS = 1388 * MiB;
constexpr size_t WS_LISTS = 1389 * MiB;
constexpr size_t WS_Y = 1421 * MiB;
constexpr size_t WS_END = 1933 * MiB;
static_assert(WS_H + (size_t)9 * NTOK * 256 * 2 <= WS_O, "H overlay");
constexpr int CW_TMO = 0;
constexpr int CW_BAR = 4096;
constexpr int CW_CNT = 16384;

constexpr int RING_OFF = 0, RING_BYTES = 131072;
constexpr int MISC_OFF = RING_BYTES;
constexpr int TBL_OFF = RING_BYTES + 1024;
constexpr int DESC_OFF = TBL_OFF + 3072;
constexpr int ROWS_OFF = DESC_OFF + 512;
constexpr int MAXU = 26;
constexpr int LDS_BYTES = ROWS_OFF + MAXU * 1024;
static_assert(LDS_BYTES <= 163840, "LDS");

#define RLX_AGENT __ATOMIC_RELAXED, __HIP_MEMORY_SCOPE_AGENT
#define LDS_WAIT() asm volatile("s_waitcnt lgkmcnt(0)" ::: "memory")
#define VM_WAIT() asm volatile("s_waitcnt vmcnt(0)" ::: "memory")
__device__ __forceinline__ unsigned f2bf(float f) { unsigned u = __builtin_bit_cast(unsigned, f); return (u + 0x7fffu + ((u >> 16) & 1u)) >> 16; }
__device__ __forceinline__ unsigned pk2(float lo, float hi) { return f2bf(lo) | (f2bf(hi) << 16); }
__device__ __forceinline__ unsigned cvt_pk_bf16(float lo, float hi) { unsigned r; asm volatile("v_cvt_pk_bf16_f32 %0, %1, %2" : "=v"(r) : "v"(lo), "v"(hi)); return r; }
__device__ __forceinline__ float bf_lo(unsigned u) { return __builtin_bit_cast(float, u << 16); }
__device__ __forceinline__ float bf_hi(unsigned u) { return __builtin_bit_cast(float, u & 0xffff0000u); }
__device__ __forceinline__ float fast_exp2(float x) { return __builtin_amdgcn_exp2f(x); }
__device__ __forceinline__ float sigmoidf_(float x) { return 1.f / (1.f + __expf(-x)); }

#define XB_TMO      128
#define XB_XCNT(j)  (256  + 64 * (j))
#define XB_XSUB(j)  (1280 + 64 * (j))
#define XB_XGEN(j)  (2304 + 64 * (j))
#define XB_TOP      3328
#define XB_TOPGEN   3392
#define XCD_BAR_WORDS 3456
#define XB_SPIN_CAP (1u << 22)

__device__ __forceinline__ unsigned xb_ld(unsigned* p)              { return __hip_atomic_load(p, __ATOMIC_RELAXED, __HIP_MEMORY_SCOPE_AGENT); }
__device__ __forceinline__ unsigned xb_add(unsigned* p, unsigned v) { return __hip_atomic_fetch_add(p, v, __ATOMIC_RELAXED, __HIP_MEMORY_SCOPE_AGENT); }
__device__ __forceinline__ unsigned xb_xcc_id() { return (unsigned)__builtin_amdgcn_s_getreg((3 << 11) | 20) & 0xFu; }
#define XB_SPIN(cond, bar) do { unsigned _sp = 0; while (cond) { __builtin_amdgcn_s_sleep(1); \
    if ((++_sp & 255u) == 0u) { if (xb_ld(&(bar)[XB_TMO])) break; if (_sp > XB_SPIN_CAP) { atomicAdd(&(bar)[XB_TMO], 1u); break; } } } } while (0)

struct XcdBarrier { unsigned* bar; unsigned x; volatile LAS unsigned* st; };

__device__ __forceinline__ XcdBarrier xcd_barrier_post(unsigned* bar, volatile LAS unsigned* st) {
    XcdBarrier b; b.bar = bar; b.x = xb_xcc_id(); b.st = st;
    if (threadIdx.x == 0) (void)xb_add(&bar[XB_XCNT(b.x)], 1u);
    return b;
}
__device__ __forceinline__ void xcd_barrier_complete(unsigned* bar, unsigned x, unsigned& nloc, unsigned& nx) {
    const unsigned G = gridDim.x * gridDim.y * gridDim.z;
    unsigned sum, cnt, mine, sp = 0u;
    for (;;) {
        sum = 0u; cnt = 0u; mine = 0u;
#pragma unroll
        for (unsigned j = 0; j < 16; ++j) { const unsigned c = xb_ld(&bar[XB_XCNT(j)]); sum += c; cnt += (c > 0u) ? 1u : 0u; mine = (j == x) ? c : mine; }
        if (sum == G) break;
        __builtin_amdgcn_s_sleep(1);
        if ((++sp & 255u) == 0u) { if (xb_ld(&bar[XB_TMO])) break; if (sp > XB_SPIN_CAP) { atomicAdd(&bar[XB_TMO], 1u); break; } }
    }
    nloc = mine > 0u ? mine : 1u; nx = cnt > 0u ? cnt : 1u;
}
__device__ __forceinline__ void xcd_barrier(const XcdBarrier& b) {
    asm volatile("s_waitcnt vmcnt(0)" ::: "memory");
    __syncthreads();
    if (threadIdx.x == 0) {
        unsigned* bar = b.bar;
        __builtin_amdgcn_s_waitcnt(0);
        unsigned nloc = b.st[0], nx = b.st[1];
        if (nloc == 0u) { xcd_barrier_complete(bar, b.x, nloc, nx); b.st[0] = nloc; b.st[1] = nx; }
        const unsigned old = xb_add(&bar[XB_XSUB(b.x)], 1u);
        const unsigned gen = old / nloc;
        if (old + 1u == (gen + 1u) * nloc) {
            __builtin_amdgcn_fence(__ATOMIC_RELEASE, "agent");
            asm volatile("s_waitcnt vmcnt(0)" ::: "memory");
            const unsigned og = xb_add(&bar[XB_TOP], 1u);
            const unsigned tg = og / nx;
            if (og + 1u == (tg + 1u) * nx) xb_add(&bar[XB_TOPGEN], 1u);
            else XB_SPIN(xb_ld(&bar[XB_TOPGEN]) == tg, bar);
            __builtin_amdgcn_fence(__ATOMIC_ACQUIRE, "agent");
            xb_add(&bar[XB_XGEN(b.x)], 1u);
            asm volatile("s_waitcnt vmcnt(0)" ::: "memory");
        } else {
            XB_SPIN(xb_ld(&bar[XB_XGEN(b.x)]) == gen, bar);
            __builtin_amdgcn_fence(__ATOMIC_ACQUIRE, "agent");
            asm volatile("s_waitcnt vmcnt(0)" ::: "memory");
        }
    }
    __syncthreads();
}

namespace g8 {
constexpr int BM = 256, BK = 64, HALF = 128, HTB = HALF * BK * 2, STAGE_BYTES = 8 * HTB, NXCD = 8, WGM = 8;
__host__ __device__ __forceinline__ int lds_byte(int r, int c) { const int st = (r >> 4) * 2 + (c >> 5), rr = r & 15, cc = c & 31, ob = rr * 64 + cc * 2; return st * 1024 + (ob ^ (((ob >> 9) & 1) << 5)); }
__host__ __device__ __forceinline__ void stage_rc(int b, int& R, int& C) { const int st = b / 1024, sb = b % 1024, swz = sb ^ (((sb >> 9) & 1) << 5); R = (st >> 1) * 16 + swz / 64; C = (st & 1) * 32 + (swz % 64) / 2; }
__host__ __device__ __forceinline__ int perm32(int rho) { const int n = rho >> 4, i = rho & 15; return 8 * (i >> 2) + 4 * n + (i & 3); }

struct GUnit { int pm, pn, e, cnt; };

struct StaticOrder {
    int nM, nN, nwg, G, c;
    __device__ void init(int nM_, int nN_, int G_, int c_) { nM = nM_; nN = nN_; nwg = nM * nN; G = G_; c = c_; }
    __device__ bool next(int i, GUnit& u) const {
        const long L = (long)i * G + c; if (L >= nwg) return false;
        int wgid = (int)L; { const int q = nwg / NXCD, r = nwg % NXCD, xcd = wgid % NXCD, off = wgid / NXCD; wgid = (xcd < r ? xcd * (q + 1) : r * (q + 1) + (xcd - r) * q) + off; }
        const int nig = WGM * nN, gid = wgid / nig, fm = gid * WGM, gsz = (nM - fm) < WGM ? (nM - fm) : WGM;
        u.pm = fm + ((wgid % nig) % gsz); u.pn = (wgid % nig) / gsz; u.e = 0; u.cnt = 256; return true;
    }
};

typedef f32x4 Acc[2][2][4][2];

template <class P>
__device__ __forceinline__ void gemm_phase(LAS unsigned char* lds, const P& p) {
    const int tid = threadIdx.x, wid = __builtin_amdgcn_readfirstlane(tid >> 6), lane = tid & 63, wr = wid >> 2, wc = wid & 3, fr = lane & 15, fq = lane >> 4;
    const int nt = p.nt;
    int Rr[2], Cc[2]; unsigned voffB[2];
#pragma unroll
    for (int i = 0; i < 2; ++i) { int R, C; stage_rc(tid * 16 + i * 8192, R, C); Rr[i] = R; Cc[i] = C; const int Rb = (R & ~31) + perm32(R & 31);
        voffB[i] = (unsigned)Rb * (unsigned)p.pitchB + (unsigned)C * 2u; }
    const size_t kstepA = p.kstepA, kstepB = p.kstepB;
    const size_t hstepB = (size_t)HALF * p.pitchB;
    const unsigned ldsw = (unsigned)wid * 1024u;
    const int aoff = lds_byte(wr * 64 + fr, fq * 8), boff = lds_byte(wc * 32 + fr, fq * 8);
#define G8_SA(b, h) (((b) * 2 + (h)) * HTB)
#define G8_SB(b, h) ((4 + (b) * 2 + (h)) * HTB)
#define G8_STAGE(bufoff, gbase, voff) do { _Pragma("unroll") for (int _i = 0; _i < 2; ++_i) \
        __builtin_amdgcn_global_load_lds((const unsigned*)((const char*)(gbase) + (voff)[_i]), (LAS unsigned*)(lds + (bufoff) + ldsw + _i * 8192), 16, 0, 0); } while (0)
#define G8_LDA(dst, b, h) do { _Pragma("unroll") for (int m = 0; m < 4; ++m) _Pragma("unroll") for (int k = 0; k < 2; ++k) dst[m][k] = *(const LAS bf16x8*)(lds + G8_SA(b, h) + aoff + m * 2048 + k * 1024); } while (0)
#define G8_LDB(dst, b, h) do { _Pragma("unroll") for (int n = 0; n < 2; ++n) _Pragma("unroll") for (int k = 0; k < 2; ++k) dst[n][k] = *(const LAS bf16x8*)(lds + G8_SB(b, h) + boff + n * 2048 + k * 1024); } while (0)
#define G8_MMA(ai, bj, At, Bt) do { __builtin_amdgcn_s_setprio(1); _Pragma("unroll") for (int m = 0; m < 4; ++m) _Pragma("unroll") for (int n = 0; n < 2; ++n) _Pragma("unroll") for (int k = 0; k < 2; ++k) \
        acc[ai][bj][m][n] = __builtin_amdgcn_mfma_f32_16x16x32_bf16(Bt[n][k], At[m][k], acc[ai][bj][m][n], 0, 0, 0); __builtin_amdgcn_s_setprio(0); } while (0)
#define G8_WAIT_V(n) asm volatile("s_waitcnt vmcnt(" #n ")" ::: "memory")
#define G8_WAIT_L(n) asm volatile("s_waitcnt lgkmcnt(" #n ")" ::: "memory")
#define G8_BAR __builtin_amdgcn_s_barrier()
#define G8_SCHED __builtin_amdgcn_sched_barrier(0)
#define G8_ZERO_ACC() do { _Pragma("unroll") for (int a = 0; a < 2; ++a) _Pragma("unroll") for (int b = 0; b < 2; ++b) _Pragma("unroll") for (int m = 0; m < 4; ++m) _Pragma("unroll") for (int n = 0; n < 2; ++n) acc[a][b][m][n] = (f32x4){0.f, 0.f, 0.f, 0.f}; } while (0)
#define G8_AOFF(dst, u) do { _Pragma("unroll") for (int _h = 0; _h < 2; ++_h) _Pragma("unroll") for (int _i = 0; _i < 2; ++_i) dst[_h][_i] = p.arow(u, _h * HALF + Rr[_i]) + (unsigned)Cc[_i] * 2u; } while (0)
    GUnit cur, nxt; int ui = 0;
    if (!p.next(0, cur)) return;
    Acc acc; G8_ZERO_ACC();
    bf16x8 At[4][2], B0[2][2], B1[2][2];
    unsigned vAc[2][2], vAn[2][2];
    G8_AOFF(vAc, cur);
    const char* const pA = (const char*)p.A;
    const char* cB = p.bptr(cur);
    G8_STAGE(G8_SB(0, 0), cB, voffB); G8_STAGE(G8_SB(0, 1), cB + hstepB, voffB); G8_STAGE(G8_SA(0, 0), pA, vAc[0]); G8_STAGE(G8_SA(0, 1), pA, vAc[1]);
    if (wr == 1) G8_BAR;
    G8_WAIT_V(2); G8_BAR;
    G8_STAGE(G8_SB(1, 0), cB + kstepB, voffB); G8_STAGE(G8_SA(1, 0), pA + kstepA, vAc[0]); G8_STAGE(G8_SB(1, 1), cB + hstepB + kstepB, voffB);
    G8_WAIT_V(6); G8_BAR;
    for (;;) {
        const bool has_next = p.next(ui + 1, nxt);
        if (has_next) { G8_AOFF(vAn, nxt); } else {
#pragma unroll
            for (int h = 0; h < 2; ++h)
#pragma unroll
                for (int i = 0; i < 2; ++i) vAn[h][i] = vAc[h][i]; }
        const char* nB = has_next ? p.bptr(nxt) : cB;
        for (int t = 0; t < nt; t += 2) {
            const bool last = (t == nt - 2);
            const char* a1 = pA + (size_t)(t + 1) * kstepA;
            const char* a2 = last ? pA : pA + (size_t)(t + 2) * kstepA; const char* b2 = last ? nB : cB + (size_t)(t + 2) * kstepB;
            const char* a3 = a2 + kstepA; const char* b3 = b2 + kstepB;
            unsigned w0[2], w1[2];
            w0[0] = last ? vAn[0][0] : vAc[0][0]; w0[1] = last ? vAn[0][1] : vAc[0][1]; w1[0] = last ? vAn[1][0] : vAc[1][0]; w1[1] = last ? vAn[1][1] : vAc[1][1];
            G8_LDB(B0, 0, 0); G8_LDB(B1, 0, 1); G8_SCHED; G8_LDA(At, 0, 0); G8_STAGE(G8_SA(1, 1), a1, vAc[1]);
            G8_WAIT_V(8); G8_WAIT_L(0); G8_BAR; G8_MMA(0, 0, At, B0); G8_MMA(0, 1, At, B1); G8_BAR; G8_SCHED;
            G8_LDA(At, 0, 1); G8_STAGE(G8_SB(0, 0), b2, voffB); G8_STAGE(G8_SB(0, 1), b2 + hstepB, voffB); G8_STAGE(G8_SA(0, 0), a2, w0);
            G8_WAIT_V(8); G8_WAIT_L(0); G8_BAR; G8_MMA(1, 0, At, B0); G8_MMA(1, 1, At, B1); G8_BAR; G8_SCHED;
            G8_LDB(B0, 1, 0); G8_LDB(B1, 1, 1); G8_SCHED; G8_LDA(At, 1, 0); G8_STAGE(G8_SA(0, 1), a2, w1);
            G8_WAIT_V(8); G8_WAIT_L(0); G8_BAR; G8_MMA(0, 0, At, B0); G8_MMA(0, 1, At, B1); G8_BAR; G8_SCHED;
            G8_LDA(At, 1, 1); G8_STAGE(G8_SB(1, 0), b3, voffB); G8_STAGE(G8_SB(1, 1), b3 + hstepB, voffB); G8_STAGE(G8_SA(1, 0), a3, w0);
            G8_WAIT_V(8); G8_WAIT_L(0); G8_BAR; G8_MMA(1, 0, At, B0); G8_MMA(1, 1, At, B1); G8_BAR; G8_SCHED;
        }
        if (wr == 0) G8_BAR;
        p.epi(acc, cur, wr, wc, fr, fq);
        if (!has_next) break;
        G8_ZERO_ACC();
        cur = nxt; cB = nB; ++ui;
#pragma unroll
        for (int h = 0; h < 2; ++h)
#pragma unroll
            for (int i = 0; i < 2; ++i) vAc[h][i] = vAn[h][i];
        if (wr == 1) G8_BAR;
    }
    G8_WAIT_V(0);
    G8_BAR;
#undef G8_SA
#undef G8_SB
#undef G8_STAGE
#undef G8_LDA
#undef G8_LDB
#undef G8_MMA
#undef G8_WAIT_V
#undef G8_WAIT_L
#undef G8_BAR
#undef G8_SCHED
#undef G8_ZERO_ACC
#undef G8_AOFF
}
}
using g8::GUnit; using g8::Acc;

struct Frame {
    LAS unsigned char* lds;
    volatile LAS unsigned* MISC;
    unsigned* ctl;
    unsigned char* ws;
    const float* in[26];
    float* out;
    int tid, lane, wave, G, bid;
};
struct Args { const float* in[26]; float* out; unsigned char* ws; int ph_lo, ph_hi; };

#define EPI_FOR_ROWS(ai, m) _Pragma("unroll") for (int ai = 0; ai < 2; ++ai) _Pragma("unroll") for (int m = 0; m < 4; ++m)

struct PlainBase {
    const bf16* A; const bf16* Bt; int nt; size_t kstepA, kstepB; unsigned pitchA, pitchB; g8::StaticOrder S;
    __device__ __forceinline__ void setup(const bf16* A_, const bf16* Bt_, int M, int N, int K, int G, int c) { A = A_; Bt = Bt_; nt = K / 64; kstepA = 128; kstepB = 128; pitchA = (unsigned)K * 2u; pitchB = (unsigned)K * 2u; S.init(M / 256, N / 256, G, c); }
    __device__ __forceinline__ bool next(int i, GUnit& u) const { return S.next(i, u); }
    __device__ __forceinline__ unsigned arow(const GUnit& u, int row) const { return (unsigned)(u.pm * 256 + row) * pitchA; }
    __device__ __forceinline__ const char* bptr(const GUnit& u) const { return (const char*)Bt + (size_t)u.pn * 256 * pitchB; }
};
struct PolBf16 : PlainBase {
    bf16* O; int ldc;
    __device__ __forceinline__ void epi(const Acc& acc, const GUnit& u, int wr, int wc, int fr, int fq) const {
        EPI_FOR_ROWS(ai, m) { const int row = u.pm * 256 + ai * 128 + wr * 64 + m * 16 + fr;
#pragma unroll
            for (int bj = 0; bj < 2; ++bj) { const int col = u.pn * 256 + bj * 128 + wc * 32 + fq * 8; const f32x4 v0 = acc[ai][bj][m][0], v1 = acc[ai][bj][m][1];
                v4u w; w.x = cvt_pk_bf16(v0[0], v0[1]); w.y = cvt_pk_bf16(v0[2], v0[3]); w.z = cvt_pk_bf16(v1[0], v1[1]); w.w = cvt_pk_bf16(v1[2], v1[3]);
                *(v4u*)(O + (size_t)row * ldc + col) = w; } }
    }
};
struct PolF32 : PlainBase {
    float* O; int ldc;
    __device__ __forceinline__ void epi(const Acc& acc, const GUnit& u, int wr, int wc, int fr, int fq) const {
        EPI_FOR_ROWS(ai, m) { const int row = u.pm * 256 + ai * 128 + wr * 64 + m * 16 + fr;
#pragma unroll
            for (int bj = 0; bj < 2; ++bj) { const int col = u.pn * 256 + bj * 128 + wc * 32 + fq * 8; float* o = O + (size_t)row * ldc + col;
                *(f32x4*)o = acc[ai][bj][m][0]; *(f32x4*)(o + 4) = acc[ai][bj][m][1]; } }
    }
};
struct PolResid : PlainBase {
    const float* X; float* PRE;
    __device__ __forceinline__ void epi(const Acc& acc, const GUnit& u, int wr, int wc, int fr, int fq) const {
        EPI_FOR_ROWS(ai, m) { const int row = u.pm * 256 + ai * 128 + wr * 64 + m * 16 + fr;
#pragma unroll
            for (int bj = 0; bj < 2; ++bj) { const int col = u.pn * 256 + bj * 128 + wc * 32 + fq * 8; const size_t o = (size_t)row * D + col;
                const f32x4 x0 = *(const f32x4*)(X + o), x1 = *(const f32x4*)(X + o + 4);
                *(f32x4*)(PRE + o) = x0 * ALPHA + acc[ai][bj][m][0]; *(f32x4*)(PRE + o + 4) = x1 * ALPHA + acc[ai][bj][m][1]; } }
    }
};
struct PolPle : PlainBase {
    const float* X; float* PRE; const float* bias; const bf16* PP;
    __device__ __forceinline__ void epi(const Acc& acc, const GUnit& u, int wr, int wc, int fr, int fq) const {
        EPI_FOR_ROWS(ai, m) { const int row = u.pm * 256 + ai * 128 + wr * 64 + m * 16 + fr;
#pragma unroll
            for (int bj = 0; bj < 2; ++bj) { const int col = u.pn * 256 + bj * 128 + wc * 32 + fq * 8; const size_t o = (size_t)row * D + col;
                const f32x4 x0 = *(const f32x4*)(X + o), x1 = *(const f32x4*)(X + o + 4);
                const f32x4 b0 = *(const f32x4*)(bias + col), b1 = *(const f32x4*)(bias + col + 4);
                const v4u pp = *(const v4u*)(PP + o);
                const f32x4 a0 = acc[ai][bj][m][0] + b0, a1 = acc[ai][bj][m][1] + b1;
                f32x4 r0, r1;
                r0[0] = x0[0] * ALPHA + sigmoidf_(a0[0]) * bf_lo(pp.x); r0[1] = x0[1] * ALPHA + sigmoidf_(a0[1]) * bf_hi(pp.x);
                r0[2] = x0[2] * ALPHA + sigmoidf_(a0[2]) * bf_lo(pp.y); r0[3] = x0[3] * ALPHA + sigmoidf_(a0[3]) * bf_hi(pp.y);
                r1[0] = x1[0] * ALPHA + sigmoidf_(a1[0]) * bf_lo(pp.z); r1[1] = x1[1] * ALPHA + sigmoidf_(a1[1]) * bf_hi(pp.z);
                r1[2] = x1[2] * ALPHA + sigmoidf_(a1[2]) * bf_lo(pp.w); r1[3] = x1[3] * ALPHA + sigmoidf_(a1[3]) * bf_hi(pp.w);
                *(f32x4*)(PRE + o) = r0; *(f32x4*)(PRE + o + 4) = r1; } }
    }
};
__device__ __forceinline__ float silu_(float x) { return x / (1.f + __expf(-x)); }
struct PolSwigluPlain : PlainBase {
    bf16* H; size_t rowbase;
    __device__ __forceinline__ void epi(const Acc& acc, const GUnit& u, int wr, int wc, int fr, int fq) const {
        EPI_FOR_ROWS(ai, m) { const int row = u.pm * 256 + ai * 128 + wr * 64 + m * 16 + fr; const int col = u.pn * 128 + wc * 32 + fq * 8;
            const f32x4 g0 = acc[ai][0][m][0], g1 = acc[ai][0][m][1], u0 = acc[ai][1][m][0], u1 = acc[ai][1][m][1];
            v4u w; w.x = cvt_pk_bf16(silu_(g0[0]) * u0[0], silu_(g0[1]) * u0[1]); w.y = cvt_pk_bf16(silu_(g0[2]) * u0[2], silu_(g0[3]) * u0[3]);
            w.z = cvt_pk_bf16(silu_(g1[0]) * u1[0], silu_(g1[1]) * u1[1]); w.w = cvt_pk_bf16(silu_(g1[2]) * u1[2], silu_(g1[3]) * u1[3]);
            *(v4u*)(H + (rowbase + row) * 256 + col) = w; }
    }
};
__device__ __forceinline__ float gelu_tanh_(float x) { const float u = 0.7978845608028654f * (x + 0.044715f * x * x * x); const float e = __expf(2.f * u); const float t = 1.f - 2.f / (e + 1.f); return 0.5f * x * (1.f + t); }
struct PolCmp1 {
    const bf16* A; const bf16* Bt; int nt; size_t kstepA, kstepB; unsigned pitchB; g8::StaticOrder S; const float* b1p; bf16* HMID;
    __device__ __forceinline__ bool next(int i, GUnit& u) const { return S.next(i, u); }
    __device__ __forceinline__ unsigned arow(const GUnit& u, int row) const {
        const int r = u.pm * 256 + row, j = r >> 13, rr = r & 8191, bg = rr >> 8, c = rr & 255, b = bg >> 2, g = bg & 3, cc = c > 254 ? 254 : c;
        return (unsigned)(((b * SEQ + 16 * cc) * 1024 + j * 256 + g * 64) * 2);
    }
    __device__ __forceinline__ const char* bptr(const GUnit& u) const { return (const char*)Bt + (size_t)(u.pm >> 5) * 256 * 2048 * 2; }
    __device__ __forceinline__ void epi(const Acc& acc, const GUnit& u, int wr, int wc, int fr, int fq) const {
        const int j = u.pm >> 5;
        EPI_FOR_ROWS(ai, m) { const int row = u.pm * 256 + ai * 128 + wr * 64 + m * 16 + fr; const int col = wc * 32 + fq * 8;
            const f32x4 b0 = *(const f32x4*)(b1p + j * 128 + col), b1 = *(const f32x4*)(b1p + j * 128 + col + 4);
            const f32x4 v0 = acc[ai][0][m][0] + b0, v1 = acc[ai][0][m][1] + b1;
            v4u w; w.x = cvt_pk_bf16(gelu_tanh_(v0[0]), gelu_tanh_(v0[1])); w.y = cvt_pk_bf16(gelu_tanh_(v0[2]), gelu_tanh_(v0[3]));
            w.z = cvt_pk_bf16(gelu_tanh_(v1[0]), gelu_tanh_(v1[1])); w.w = cvt_pk_bf16(gelu_tanh_(v1[2]), gelu_tanh_(v1[3]));
            *(v4u*)(HMID + (size_t)row * 128 + col) = w; }
    }
};
struct GroupedBase {
    const bf16* A; const bf16* Wb; int nt; size_t kstepA, kstepB; unsigned pitchA, pitchB; int nu; size_t wstride_e, wstride_pn;
    const LAS int* desc; const LAS int* rows;
    __device__ __forceinline__ bool next(int i, GUnit& u) const { if (i >= nu) return false; u.pm = i; u.e = desc[i * 4 + 0]; u.pn = desc[i * 4 + 1]; u.cnt = desc[i * 4 + 2]; return true; }
    __device__ __forceinline__ const char* bptr(const GUnit& u) const { return (const char*)Wb + (size_t)u.e * wstride_e + (size_t)u.pn * wstride_pn; }
};
struct PolSwigluGrouped : GroupedBase {
    bf16* H;
    __device__ __forceinline__ unsigned arow(const GUnit& u, int row) const { const int a = rows[u.pm * 256 + row]; return a < 0 ? 0u : (unsigned)(a >> 3) * pitchA; }
    __device__ __forceinline__ void epi(const Acc& acc, const GUnit& u, int wr, int wc, int fr, int fq) const {
        EPI_FOR_ROWS(ai, m) { const int row = ai * 128 + wr * 64 + m * 16 + fr; const int a = rows[u.pm * 256 + row]; const int col = u.pn * 128 + wc * 32 + fq * 8;
            if (a >= 0) {
            const f32x4 g0 = acc[ai][0][m][0], g1 = acc[ai][0][m][1], u0 = acc[ai][1][m][0], u1 = acc[ai][1][m][1];
            v4u w; w.x = cvt_pk_bf16(silu_(g0[0]) * u0[0], silu_(g0[1]) * u0[1]); w.y = cvt_pk_bf16(silu_(g0[2]) * u0[2], silu_(g0[3]) * u0[3]);
            w.z = cvt_pk_bf16(silu_(g1[0]) * u1[0], silu_(g1[1]) * u1[1]); w.w = cvt_pk_bf16(silu_(g1[2]) * u1[2], silu_(g1[3]) * u1[3]);
            *(v4u*)(H + (size_t)a * 256 + col) = w; } }
    }
};
struct PolDownGrouped : GroupedBase {
    bf16* Y; const float* wts;
    __device__ __forceinline__ unsigned arow(const GUnit& u, int row) const { const int a = rows[u.pm * 256 + row]; return a < 0 ? 0u : (unsigned)a * pitchA; }
    __device__ __forceinline__ void epi(const Acc& acc, const GUnit& u, int wr, int wc, int fr, int fq) const {
        EPI_FOR_ROWS(ai, m) { const int row = ai * 128 + wr * 64 + m * 16 + fr; const int a = rows[u.pm * 256 + row];
            if (a >= 0) { const float w8 = wts[a];
#pragma unroll
            for (int bj = 0; bj < 2; ++bj) { const int col = u.pn * 256 + bj * 128 + wc * 32 + fq * 8; const f32x4 v0 = acc[ai][bj][m][0] * w8, v1 = acc[ai][bj][m][1] * w8;
                v4u w; w.x = cvt_pk_bf16(v0[0], v0[1]); w.y = cvt_pk_bf16(v0[2], v0[3]); w.z = cvt_pk_bf16(v1[0], v1[1]); w.w = cvt_pk_bf16(v1[2], v1[3]);
                *(v4u*)(Y + (size_t)a * D + col) = w; } } }
    }
};

__device__ __forceinline__ float wave_sum(float v) {
#pragma unroll
    for (int o = 1; o < 64; o <<= 1) v += __shfl_xor(v, o);
    return v;
}
__device__ __forceinline__ void tr_item(const float* W, int ldw, int k0, int n0, bf16* WT, int dstK, int drow0, float scale, LAS float* scr, int lane) {
#pragma unroll 8
    for (int i = 0; i < 32; ++i) { const int kk = 2 * i + (lane >> 5); scr[kk * 33 + (lane & 31)] = W[(size_t)(k0 + kk) * ldw + n0 + (lane & 31)] * scale; }
    LDS_WAIT(); asm volatile("" ::: "memory");
    const int c = lane & 7;
#pragma unroll
    for (int j = 0; j < 4; ++j) { const int n = (lane >> 3) + 8 * j; const LAS float* s = scr + (8 * c) * 33 + n;
        v4u o; o.x = pk2(s[0 * 33], s[1 * 33]); o.y = pk2(s[2 * 33], s[3 * 33]); o.z = pk2(s[4 * 33], s[5 * 33]); o.w = pk2(s[6 * 33], s[7 * 33]);
        *(v4u*)(WT + (size_t)(drow0 + n) * dstK + k0 + 8 * c) = o; }
    LDS_WAIT(); asm volatile("" ::: "memory");
}
struct TJob { const float* src; int K, ldw, col0, ncols; bf16* dst; int dstK, drow0; float scale; };
__device__ __forceinline__ void tr_job_item(const TJob& j, int item, LAS float* scr, int lane) {
    const int nblk = j.ncols / 32, kb = item / nblk, nb = item % nblk;
    tr_item(j.src, j.ldw, 64 * kb, j.col0 + 32 * nb, j.dst, j.dstK, j.drow0 + 32 * nb, j.scale, scr, lane);
}
constexpr int N_SMALL_JOBS = 36;
__device__ __forceinline__ TJob small_job(const Frame& F, int j) {
    unsigned char* ws = F.ws; const float* const (&in)[26] = F.in;
    TJob t; t.scale = 1.f; t.col0 = 0; t.drow0 = 0;
    if (j < 3) {
        t.src = in[2]; t.K = 1024; t.ldw = 3088; t.col0 = 1024 * j; t.ncols = 1024; t.dstK = 1024;
        if (j == 0) { t.dst = (bf16*)(ws + WS_W_FQK); t.scale = QSCALE; } else if (j == 1) { t.dst = (bf16*)(ws + WS_W_FQK); t.drow0 = 1024; } else t.dst = (bf16*)(ws + WS_W_FV);
    } else if (j == 3) { t.src = in[4]; t.K = 1024; t.ldw = 1024; t.ncols = 1024; t.dst = (bf16*)(ws + WS_W_FO); t.dstK = 1024;
    } else if (j < 10) {
        const int s = j - 4; t.src = in[5]; t.K = 1024; t.ldw = 1536; t.col0 = 256 * s; t.ncols = 256; t.dstK = 1024;
        if (s == 3) { t.dst = (bf16*)(ws + WS_W_KVTR); t.drow0 = 0; } else if (s == 5) { t.dst = (bf16*)(ws + WS_W_KVTR); t.drow0 = 256; } else { t.dst = (bf16*)(ws + WS_W_KVTOK); t.drow0 = (s == 0) ? 0 : (s == 1) ? 256 : (s == 2) ? 512 : 768; }
    } else if (j == 10) { t.src = in[10]; t.K = 1024; t.ldw = 1072; t.ncols = 1024; t.dst = (bf16*)(ws + WS_W_NQ); t.dstK = 1024; t.scale = QSCALE;
    } else if (j == 11) { t.src = in[12]; t.K = 1024; t.ldw = 1024; t.ncols = 1024; t.dst = (bf16*)(ws + WS_W_NO); t.dstK = 1024;
    } else if (j < 14) { const int L = j - 12; t.src = in[15] + (size_t)L * 1024 * 256; t.K = 1024; t.ldw = 256; t.ncols = 256; t.dst = (bf16*)(ws + WS_W_RT) + (size_t)L * 256 * 1024; t.dstK = 1024;
    } else if (j < 22) {
        const int q = j - 14, L = q >> 2, which = (q >> 1) & 1, half = q & 1;
        t.src = (which ? in[21] : in[20]) + (size_t)L * 1024 * 256; t.K = 1024; t.ldw = 256; t.col0 = 128 * half; t.ncols = 128; t.dst = (bf16*)(ws + WS_W_SGU) + (size_t)L * 512 * 1024; t.dstK = 1024; t.drow0 = half * 256 + which * 128;
    } else if (j < 24) { const int L = j - 22; t.src = in[22] + (size_t)L * 256 * 1024; t.K = 256; t.ldw = 1024; t.ncols = 1024; t.dst = (bf16*)(ws + WS_W_SD) + (size_t)L * 1024 * 256; t.dstK = 256;
    } else if (j < 26) { const int L = j - 24; t.src = in[23] + (size_t)L * 256 * 1024; t.K = 256; t.ldw = 1024; t.ncols = 1024; t.dst = (bf16*)(ws + WS_W_PP) + (size_t)L * 1024 * 256; t.dstK = 256;
    } else if (j < 28) { const int L = j - 26; t.src = in[24] + (size_t)L * 1024 * 1024; t.K = 1024; t.ldw = 1024; t.ncols = 1024; t.dst = (bf16*)(ws + WS_W_PG) + (size_t)L * 1024 * 1024; t.dstK = 1024;
    } else if (j < 30) { const int jj = j - 28; t.src = in[7] + (size_t)jj * 2048 * 128; t.K = 2048; t.ldw = 128; t.ncols = 128; t.dst = (bf16*)(ws + WS_W_C1) + (size_t)jj * 256 * 2048; t.dstK = 2048;
    } else { t.src = nullptr; t.K = 0; t.ldw = 0; t.ncols = 32; t.dst = nullptr; t.dstK = 0; }
    return t;
}
__device__ __forceinline__ void p_prologue(Frame& F) {
    LAS float* scr = (LAS float*)(F.lds + RING_OFF + F.wave * 16384);
    const int gw = F.bid * NWAVES + F.wave, NGW = F.G * NWAVES;
    unsigned char* ws = F.ws;
    for (int j = 0; j < 30; ++j) {
        const TJob t = small_job(F, j);
        const int items = (t.K / 64) * (t.ncols / 32);
        for (int it = gw; it < items; it += NGW) tr_job_item(t, it, scr, F.lane);
    }
    {
        const long total = 512L * 384;
        for (long it = gw; it < total; it += NGW) {
            const int le = (int)(it / 384), r = (int)(it % 384), which = r >> 7, idx = r & 127;
            if (which < 2) {
                const float* src = (which ? F.in[18] : F.in[17]) + (size_t)le * 1024 * 256;
                const int kb = idx >> 3, nb = idx & 7, n0 = 32 * nb;
                bf16* dst = (bf16*)(ws + WS_W_EGU) + (size_t)le * 512 * 1024;
                tr_item(src, 256, 64 * kb, n0, dst, 1024, (n0 >> 7) * 256 + which * 128 + (n0 & 127), 1.f, scr, F.lane);
            } else {
                const float* src = F.in[19] + (size_t)le * 256 * 1024;
                const int kb = idx >> 5, nb = idx & 31;
                bf16* dst = (bf16*)(ws + WS_W_ED) + (size_t)le * 1024 * 256;
                tr_item(src, 1024, 64 * kb, 32 * nb, dst, 256, 32 * nb, 1.f, scr, F.lane);
            }
        }
    }
    {
        const size_t gt = (size_t)F.bid * NTHREADS + F.tid, NT = (size_t)F.G * NTHREADS;
        const float* x = F.in[0]; bf16* xb = (bf16*)(ws + WS_XB);
        for (size_t i = gt; i < (size_t)NTOK * D / 8; i += NT) { const f32x4 a = *(const f32x4*)(x + i * 8), b = *(const f32x4*)(x + i * 8 + 4);
            v4u w; w.x = pk2(a[0], a[1]); w.y = pk2(a[2], a[3]); w.z = pk2(b[0], b[1]); w.w = pk2(b[2], b[3]); *(v4u*)(xb + i * 8) = w; }
        const float* pp = F.in[1]; bf16* pb = (bf16*)(ws + WS_PB);
        for (size_t i = gt; i < (size_t)2 * NTOK * PLE / 8; i += NT) { const f32x4 a = *(const f32x4*)(pp + i * 8), b = *(const f32x4*)(pp + i * 8 + 4);
            v4u w; w.x = pk2(a[0], a[1]); w.y = pk2(a[2], a[3]); w.z = pk2(b[0], b[1]); w.w = pk2(b[2], b[3]); *(v4u*)(pb + i * 8) = w; }
        bf16* wc1 = (bf16*)(ws + WS_W_C1);
        for (size_t i = gt; i < (size_t)2 * 128 * 2048 / 8; i += NT) { const size_t jj = i / (128 * 2048 / 8), r = i % (128 * 2048 / 8); *(v4u*)(wc1 + jj * 256 * 2048 + 128 * 2048 + r * 8) = (v4u){0u, 0u, 0u, 0u}; }
    }
    if (F.bid == 0 && F.tid < 256) {
        const int j = F.tid >> 7, col = F.tid & 127; const float* pe = F.in[6] + j * 2048; const float* w1 = F.in[7] + (size_t)j * 2048 * 128 + col;
        float s = F.in[8][j * 128 + col];
        for (int k = 0; k < 2048; ++k) s += pe[k] * w1[(size_t)k * 128];
        ((float*)(ws + WS_B1P))[j * 128 + col] = s;
    }
}

template <int NC, int ACT>
__device__ __forceinline__ void p_smallproj(Frame& F, const float* X, const float* W, int ldw, int col0, const float* bias, float* OUT) {
    constexpr int RPB = NTHREADS / NC;
    constexpr int KC = 256;
    LAS float* wl = (LAS float*)(F.lds + RING_OFF);
    const int r = F.tid / NC, c = F.tid % NC; const bool act = r < RPB;
    const int niter = (NTOK + RPB - 1) / RPB;
    for (int it = F.bid; it < niter; it += F.G) {
        const int row = it * RPB + r; const bool ok = act && row < NTOK;
        float s = 0.f;
        for (int kc = 0; kc < D; kc += KC) {
            __syncthreads();
            for (int i = F.tid; i < KC * NC; i += NTHREADS) { const int kk = i / NC, cc = i % NC; wl[i] = W[(size_t)(kc + kk) * ldw + col0 + cc]; }
            __syncthreads();
            if (ok) { const float* xr = X + (size_t)row * D + kc;
#pragma unroll 4
                for (int k = 0; k < KC; k += 4) { const f32x4 xv = *(const f32x4*)(xr + k);
                    s += xv[0] * wl[(k + 0) * NC + c]; s += xv[1] * wl[(k + 1) * NC + c]; s += xv[2] * wl[(k + 2) * NC + c]; s += xv[3] * wl[(k + 3) * NC + c]; } }
        }
        if (ok) { const float z = s + bias[c]; float o;
            if (ACT == 0) o = fminf(z, 0.f) - log1pf(__expf(-fabsf(z))); else o = sigmoidf_(z);
            OUT[(size_t)row * NC + c] = o; }
    }
    __syncthreads();
}
__device__ __forceinline__ void p_scan(Frame& F) {
    if (F.bid >= NB) return;
    const float* lf = (const float*)(F.ws + WS_LOGF) + (size_t)F.bid * SEQ * 16; float* c2 = (float*)(F.ws + WS_C2) + (size_t)F.bid * SEQ * 16;
    LAS float* sums = (LAS float*)(F.lds + RING_OFF);
    const int h = F.tid & 15, ch = F.tid >> 4;
    float s = 0.f;
    for (int i = 0; i < 128; ++i) s += lf[(size_t)(ch * 128 + i) * 16 + h];
    sums[ch * 16 + h] = s;
    __syncthreads();
    float run = 0.f;
    for (int q = 0; q < ch; ++q) run += sums[q * 16 + h];
    for (int i = 0; i < 128; ++i) { run += lf[(size_t)(ch * 128 + i) * 16 + h]; c2[(size_t)(ch * 128 + i) * 16 + h] = run * LOG2E; }
    __syncthreads();
}

template <int MODE, bool WRITE_XB>
__device__ __forceinline__ void p_ln(Frame& F, float* PRE, const bf16* Y, const float* g, const float* b, bf16* XB) {
    const int gw = F.bid * NWAVES + F.wave, NGW = F.G * NWAVES;
    f32x4 gv[4], bv[4];
#pragma unroll
    for (int j = 0; j < 4; ++j) { gv[j] = *(const f32x4*)(g + 4 * F.lane + 256 * j); bv[j] = *(const f32x4*)(b + 4 * F.lane + 256 * j); }
    for (int row = gw; row < NTOK; row += NGW) {
        float* pr = PRE + (size_t)row * D + 4 * F.lane;
        f32x4 v[4]; float s = 0.f;
#pragma unroll
        for (int j = 0; j < 4; ++j) v[j] = *(const f32x4*)(pr + 256 * j);
        if (MODE == 1) {
#pragma unroll
            for (int k = 0; k < 8; ++k) { const bf16* yr = Y + ((size_t)row * 8 + k) * D + 4 * F.lane;
#pragma unroll
                for (int j = 0; j < 4; ++j) { const v2u w = *(const v2u*)(yr + 256 * j); v[j][0] += bf_lo(w.x); v[j][1] += bf_hi(w.x); v[j][2] += bf_lo(w.y); v[j][3] += bf_hi(w.y); } }
        }
#pragma unroll
        for (int j = 0; j < 4; ++j) s += (v[j][0] + v[j][1]) + (v[j][2] + v[j][3]);
        const float mean = wave_sum(s) * (1.f / D); float s2 = 0.f;
#pragma unroll
        for (int j = 0; j < 4; ++j) { v[j] = v[j] - mean; s2 += (v[j][0] * v[j][0] + v[j][1] * v[j][1]) + (v[j][2] * v[j][2] + v[j][3] * v[j][3]); }
        const float rstd = 1.f / sqrtf(wave_sum(s2) * (1.f / D) + LN_EPS);
#pragma unroll
        for (int j = 0; j < 4; ++j) { const f32x4 o = v[j] * rstd * gv[j] + bv[j]; *(f32x4*)(pr + 256 * j) = o;
            if (WRITE_XB) { v2u w; w.x = pk2(o[0], o[1]); w.y = pk2(o[2], o[3]); *(v2u*)(XB + (size_t)row * D + 4 * F.lane + 256 * j) = w; } }
    }
}

__device__ __forceinline__ void p_route(Frame& F, int L) {
    const int gw = F.bid * NWAVES + F.wave, NGW = F.G * NWAVES, lane = F.lane;
    const float* SC = (const float*)(F.ws + WS_SCORES); const float* br = F.in[16] + L * NE;
    unsigned* cnt = F.ctl + CW_CNT + L * NE; int* lists = (int*)(F.ws + WS_LISTS); float* wts = (float*)(F.ws + WS_WTS);
    const f32x4 bq = *(const f32x4*)(br + 4 * lane);
    for (int t = gw; t < NTOK; t += NGW) {
        const f32x4 lg = *(const f32x4*)(SC + (size_t)t * NE + 4 * lane);
        float sc[4], bs[4];
#pragma unroll
        for (int i = 0; i < 4; ++i) { sc[i] = sigmoidf_(lg[i]); bs[i] = sc[i] + bq[i]; }
        float m1 = fmaxf(bs[0], bs[1]), m2 = fminf(bs[0], bs[1]);
        { const float a = bs[2]; const float n1 = fmaxf(m1, a); m2 = fmaxf(fminf(m1, a), m2); m1 = n1; }
        { const float a = bs[3]; const float n1 = fmaxf(m1, a); m2 = fmaxf(fminf(m1, a), m2); m1 = n1; }
#pragma unroll
        for (int o = 1; o < 8; o <<= 1) { const float o1 = __shfl_xor(m1, o), o2 = __shfl_xor(m2, o); const float n1 = fmaxf(m1, o1); m2 = fmaxf(fminf(m1, o1), fmaxf(m2, o2)); m1 = n1; }
        const float gs = m1 + m2; const int mygrp = lane >> 3;
        int rank = 0;
#pragma unroll
        for (int gg = 0; gg < 8; ++gg) { const float og = __shfl(gs, gg * 8); rank += (og > gs || (og == gs && gg < mygrp)) ? 1 : 0; }
        const bool gsel = rank < 4;
        float cand[4];
#pragma unroll
        for (int i = 0; i < 4; ++i) cand[i] = gsel ? bs[i] : NEGBIG;
        float ssel = 0.f; int esel = 0; float ssum = 0.f;
#pragma unroll 1
        for (int k = 0; k < TOPK; ++k) {
            float bv = cand[0]; int bi = 4 * lane;
#pragma unroll
            for (int i = 1; i < 4; ++i) if (cand[i] > bv) { bv = cand[i]; bi = 4 * lane + i; }
#pragma unroll
            for (int o = 1; o < 64; o <<= 1) { const float ov = __shfl_xor(bv, o); const int oi = __shfl_xor(bi, o); if (ov > bv || (ov == bv && oi < bi)) { bv = ov; bi = oi; } }
            const int own = bi >> 2, sub = bi & 3;
            float sv = sub == 0 ? sc[0] : sub == 1 ? sc[1] : sub == 2 ? sc[2] : sc[3];
            sv = __shfl(sv, own);
            if (lane == own) { if (sub == 0) cand[0] = -3e38f; else if (sub == 1) cand[1] = -3e38f; else if (sub == 2) cand[2] = -3e38f; else cand[3] = -3e38f; }
            ssum += sv;
            if (lane == k) { ssel = sv; esel = bi; }
        }
        if (lane < TOPK) {
            const float w = ssel / ssum * 2.5f;
            const unsigned pos = atomicAdd(&cnt[esel], 1u);
            lists[(size_t)esel * NTOK + pos] = t * 8 + lane;
            wts[t * 8 + lane] = w;
        }
    }
}
__device__ __forceinline__ int build_units(Frame& F, int L, int nN) {
    LAS int* cum = (LAS int*)(F.lds + TBL_OFF); LAS int* cn = cum + 260; LAS int* desc = (LAS int*)(F.lds + DESC_OFF); LAS int* rows = (LAS int*)(F.lds + ROWS_OFF);
    const int* lists = (const int*)(F.ws + WS_LISTS);
    __syncthreads();
    if (F.tid < NE) { const int c = (int)__hip_atomic_load(F.ctl + CW_CNT + L * NE + F.tid, RLX_AGENT); cn[F.tid] = c; }
    __syncthreads();
    if (F.tid <= NE) { int s = 0; for (int i = 0; i < F.tid; ++i) s += (cn[i] + 255) >> 8; cum[F.tid] = s; }
    __syncthreads();
    const int total = cum[NE] * nN;
    int nu = 0;
    for (int i = 0; i < MAXU; ++i) {
        const int Lu = i * F.G + F.bid; if (Lu >= total) break;
        const int mt = Lu / nN, pn = Lu % nN;
        int lo = 0, hi = NE;
        while (hi - lo > 1) { const int mid = (lo + hi) >> 1; if (cum[mid] <= mt) lo = mid; else hi = mid; }
        const int e = lo, r0 = (mt - cum[e]) * 256; int cnt = cn[e] - r0; cnt = cnt > 256 ? 256 : cnt;
        if (F.tid == 0) { desc[i * 4 + 0] = e; desc[i * 4 + 1] = pn; desc[i * 4 + 2] = cnt; desc[i * 4 + 3] = r0; }
        if (F.tid < 256) rows[i * 256 + F.tid] = F.tid < cnt ? lists[(size_t)e * NTOK + r0 + F.tid] : -1;
        nu = i + 1;
    }
    __syncthreads();
    return nu;
}

__device__ __forceinline__ void p_cmp2(Frame& F) {
    LAS float* w2 = (LAS float*)(F.lds + RING_OFF);
    for (int i = F.tid; i < 2 * 128 * 64; i += NTHREADS) w2[i] = F.in[9][i];
    __syncthreads();
    const bf16* hm = (const bf16*)(F.ws + WS_HMID); bf16* kc = (bf16*)(F.ws + WS_KC); bf16* vct = (bf16*)(F.ws + WS_VCT);
    const int total = 2 * 8192 * 16;
    for (int it = F.bid * NTHREADS + F.tid; it < total; it += F.G * NTHREADS) {
        const int d4 = it & 15, r = (it >> 4) & 8191, j = it >> 17, c = r & 255, bg = r >> 8;
        float a0 = 0.f, a1 = 0.f, a2 = 0.f, a3 = 0.f;
        if (c < 255) {
            const bf16* hr = hm + ((size_t)j * 8192 + r) * 128; const LAS float* w = w2 + j * 8192 + d4 * 4;
            for (int k = 0; k < 128; k += 2) { const unsigned hh = *(const unsigned*)(hr + k); const float h0 = bf_lo(hh), h1 = bf_hi(hh);
                const f32x4 wa = *(const LAS f32x4*)(w + k * 64), wb = *(const LAS f32x4*)(w + (k + 1) * 64);
                a0 += h0 * wa[0] + h1 * wb[0]; a1 += h0 * wa[1] + h1 * wb[1]; a2 += h0 * wa[2] + h1 * wb[2]; a3 += h0 * wa[3] + h1 * wb[3]; }
        }
        if (j == 0) { v2u w; w.x = pk2(a0, a1); w.y = pk2(a2, a3); *(v2u*)(kc + ((size_t)bg * 256 + c) * 64 + d4 * 4) = w; }
        else { bf16* o = vct + ((size_t)bg * 64 + d4 * 4) * 256 + c; o[0] = (bf16)f2bf(a0); o[256] = (bf16)f2bf(a1); o[512] = (bf16)f2bf(a2); o[768] = (bf16)f2bf(a3); }
    }
    __syncthreads();
}

constexpr int KP = 144, VP = 136;
constexpr int AT_BUF = 64 * KP + 64 * VP;
constexpr int AT_CK = 2 * AT_BUF;
constexpr int AT_IMP = AT_CK + 512;
constexpr int AT_MASK = AT_IMP + 64 * 65 * 4;
constexpr int AT_UNI = AT_MASK + 512;
constexpr int AT_OACC = AT_UNI + 64;
constexpr int AT_END = AT_OACC + 32 * 512 * 4;
static_assert(AT_END <= RING_BYTES, "attention LDS");

struct TileRegs { v4u k, v; };
__device__ __forceinline__ void at_load(TileRegs& r, const bf16* kbase, size_t kpitch_e, const bf16* vbase, size_t vpitch_e, int tid) {
    const int row = tid >> 3, ch = tid & 7;
    r.k = *(const v4u*)(kbase + (size_t)row * kpitch_e + ch * 8);
    r.v = *(const v4u*)(vbase + (size_t)row * vpitch_e + ch * 8);
}
__device__ __forceinline__ void at_store(LAS unsigned char* buf, const TileRegs& r, int tid) {
    const int row = tid >> 3, ch = tid & 7;
    *(LAS v4u*)(buf + row * KP + ch * 16) = r.k;
    LAS unsigned char* vp = buf + 64 * KP + row * VP + ch * 16;
    *(LAS v2u*)(vp) = (v2u){r.v.x, r.v.y}; *(LAS v2u*)(vp + 8) = (v2u){r.v.z, r.v.w};
}
__device__ __forceinline__ void at_qk(const LAS unsigned char* buf, const bf16x8 (&Qf)[4], f32x16& S0, f32x16& S1, int lane) {
    const LAS unsigned char* kb = buf + (lane & 31) * KP + (lane >> 5) * 16;
#pragma unroll
    for (int ks = 0; ks < 4; ++ks) {
        const bf16x8 k0 = *(const LAS bf16x8*)(kb + ks * 32), k1 = *(const LAS bf16x8*)(kb + 32 * KP + ks * 32);
        S0 = __builtin_amdgcn_mfma_f32_32x32x16_bf16(k0, Qf[ks], S0, 0, 0, 0);
        S1 = __builtin_amdgcn_mfma_f32_32x32x16_bf16(k1, Qf[ks], S1, 0, 0, 0);
    }
}
__device__ __forceinline__ void at_pv(const LAS unsigned char* buf, const f32x16& P0, const f32x16& P1, f32x16& O0, f32x16& O1, int lane) {
    const LAS unsigned char* vb = buf + 64 * KP + (lane & 31) * VP + (lane >> 5) * 8;
#pragma unroll
    for (int s = 0; s < 4; ++s) {
        const f32x16& P = (s < 2) ? P0 : P1; const int rb = 8 * (s & 1);
        v4u pw; pw.x = cvt_pk_bf16(P[rb + 0], P[rb + 1]); pw.y = cvt_pk_bf16(P[rb + 2], P[rb + 3]); pw.z = cvt_pk_bf16(P[rb + 4], P[rb + 5]); pw.w = cvt_pk_bf16(P[rb + 6], P[rb + 7]);
        const bf16x8 pf = __builtin_bit_cast(bf16x8, pw);
        const v2u a0 = *(const LAS v2u*)(vb + 32 * s), a1 = *(const LAS v2u*)(vb + 32 * s + 16);
        const v2u b0 = *(const LAS v2u*)(vb + 32 * VP + 32 * s), b1 = *(const LAS v2u*)(vb + 32 * VP + 32 * s + 16);
        const bf16x8 v0 = __builtin_bit_cast(bf16x8, ((v4u){a0.x, a0.y, a1.x, a1.y})), v1 = __builtin_bit_cast(bf16x8, ((v4u){b0.x, b0.y, b1.x, b1.y}));
        O0 = __builtin_amdgcn_mfma_f32_32x32x16_bf16(v0, pf, O0, 0, 0, 0);
        O1 = __builtin_amdgcn_mfma_f32_32x32x16_bf16(v1, pf, O1, 0, 0, 0);
    }
}
#define KEY_OF(sub, reg, h) (32 * (sub) + ((reg) & 3) + 8 * ((reg) >> 2) + 4 * (h))

__device__ __forceinline__ void at_softmax(f32x16& S0, f32x16& S1, float& m, float& l, f32x16& O0, f32x16& O1) {
    float mx = S0[0];
#pragma unroll
    for (int r = 1; r < 16; ++r) mx = fmaxf(mx, S0[r]);
#pragma unroll
    for (int r = 0; r < 16; ++r) mx = fmaxf(mx, S1[r]);
    mx = fmaxf(mx, __shfl_xor(mx, 32));
    const float mn = fmaxf(m, mx), mu = fmaxf(mn, -1e20f);
    const float alpha = fast_exp2(m - mn);
    float ps = 0.f;
#pragma unroll
    for (int r = 0; r < 16; ++r) { S0[r] = fast_exp2(S0[r] - mu); ps += S0[r]; }
#pragma unroll
    for (int r = 0; r < 16; ++r) { S1[r] = fast_exp2(S1[r] - mu); ps += S1[r]; }
    ps += __shfl_xor(ps, 32);
    l = l * alpha + ps; m = mn;
    O0 = O0 * alpha; O1 = O1 * alpha;
}

__device__ __forceinline__ void p_fox_attn(Frame& F) {
    LAS unsigned char* lds = F.lds + RING_OFF;
    const bf16* QK = (const bf16*)(F.ws + WS_QK); const bf16* VT = (const bf16*)(F.ws + WS_VT); const float* C2 = (const float*)(F.ws + WS_C2); bf16* O = (bf16*)(F.ws + WS_O);
    const int tid = F.tid, lane = F.lane, w = F.wave, n = lane & 31, h = lane >> 5;
    for (int i = 0;; ++i) {
        const int idx = i * F.G + ((i & 1) ? (F.G - 1 - F.bid) : F.bid); if (idx >= NB * NH * 16) break;
        const int qb = 15 - idx / 128, bh = idx % 128, b = bh >> 4, hd = bh & 15;
        const int q0 = qb * 256, tq = q0 + 32 * w + n;
        const size_t tokq = (size_t)b * SEQ + tq;
        bf16x8 Qf[4];
#pragma unroll
        for (int ks = 0; ks < 4; ++ks) Qf[ks] = *(const bf16x8*)(QK + tokq * 2048 + hd * 64 + 16 * ks + 8 * h);
        const float cq = C2[tokq * 16 + hd];
        f32x16 O0, O1;
#pragma unroll
        for (int r = 0; r < 16; ++r) { O0[r] = 0.f; O1[r] = 0.f; }
        float m = NEGBIG, l = 0.f;
        const int ntiles = (q0 + 256) / 64;
        const bf16* kbase = QK + (size_t)b * SEQ * 2048 + 1024 + hd * 64;
        const bf16* vbase = VT + (size_t)(hd * 64) * NTOK + (size_t)b * SEQ;
        const float* cbase = C2 + (size_t)b * SEQ * 16 + hd;
        TileRegs tr; float ckr = 0.f;
        at_load(tr, kbase, 2048, vbase, NTOK, tid); if (tid < 64) ckr = cbase[(size_t)tid * 16];
        __syncthreads();
        at_store(lds, tr, tid); if (tid < 64) ((LAS float*)(lds + AT_CK))[tid] = ckr;
        __syncthreads();
#pragma unroll 1
        for (int j = 0; j < ntiles; ++j) {
            LAS unsigned char* buf = lds + (j & 1) * AT_BUF; LAS unsigned char* nbuf = lds + ((j + 1) & 1) * AT_BUF;
            if (j + 1 < ntiles) { at_load(tr, kbase + (size_t)(j + 1) * 64 * 2048, 2048, vbase + (j + 1) * 64, NTOK, tid); if (tid < 64) ckr = cbase[(size_t)((j + 1) * 64 + tid) * 16]; }
            if (64 * j <= q0 + 32 * w + 31) {
                f32x16 S0, S1;
#pragma unroll
                for (int r = 0; r < 16; ++r) { S0[r] = 0.f; S1[r] = 0.f; }
                at_qk(buf, Qf, S0, S1, lane);
                const LAS float* ck = (const LAS float*)(lds + AT_CK) + (j & 1) * 64;
                const int rel = tq - 64 * j - 4 * h;
#pragma unroll
                for (int g = 0; g < 4; ++g) {
                    const f32x4 c0 = *(const LAS f32x4*)(ck + 8 * g + 4 * h), c1 = *(const LAS f32x4*)(ck + 32 + 8 * g + 4 * h);
#pragma unroll
                    for (int e = 0; e < 4; ++e) { const int r = 4 * g + e; const int kk = 8 * g + e;
                        S0[r] = (kk <= rel) ? S0[r] + (cq - c0[e]) : NEGBIG;
                        S1[r] = (kk + 32 <= rel) ? S1[r] + (cq - c1[e]) : NEGBIG; }
                }
                at_softmax(S0, S1, m, l, O0, O1);
                at_pv(buf, S0, S1, O0, O1, lane);
            }
            if (j + 1 < ntiles) { at_store(nbuf, tr, tid); if (tid < 64) ((LAS float*)(lds + AT_CK))[((j + 1) & 1) * 64 + tid] = ckr; }
            __syncthreads();
        }
        const float inv = l > 0.f ? 1.f / l : 0.f;
        bf16* orow = O + tokq * D + hd * 64 + 4 * h;
#pragma unroll
        for (int g = 0; g < 4; ++g) {
            v2u w0; w0.x = cvt_pk_bf16(O0[4 * g] * inv, O0[4 * g + 1] * inv); w0.y = cvt_pk_bf16(O0[4 * g + 2] * inv, O0[4 * g + 3] * inv); *(v2u*)(orow + 8 * g) = w0;
            v2u w1; w1.x = cvt_pk_bf16(O1[4 * g] * inv, O1[4 * g + 1] * inv); w1.y = cvt_pk_bf16(O1[4 * g + 2] * inv, O1[4 * g + 3] * inv); *(v2u*)(orow + 32 + 8 * g) = w1;
        }
    }
}

__device__ __forceinline__ void p_nsa_attn(Frame& F) {
    LAS unsigned char* lds = F.lds + RING_OFF;
    const bf16* KVTOK = (const bf16*)(F.ws + WS_QK); const bf16* NQ = (const bf16*)(F.ws + WS_QK + 64 * MiB); const bf16* KVTR = (const bf16*)(F.ws + WS_VT);
    const bf16* KC = (const bf16*)(F.ws + WS_KC); const bf16* VCT = (const bf16*)(F.ws + WS_VCT); const float* GATES = (const float*)(F.ws + WS_GATES); bf16* O = (bf16*)(F.ws + WS_O);
    LAS float* IMP = (LAS float*)(lds + AT_IMP); LAS float* OACC = (LAS float*)(lds + AT_OACC) + F.tid; asm volatile("" : "+v"(OACC));     LAS u64* MASK = (LAS u64*)(lds + AT_MASK); LAS u64* UNI = (LAS u64*)(lds + AT_UNI);
    const int tid = F.tid, lane = F.lane, w = F.wave, n = lane & 31, h = lane >> 5, qq = n >> 2, rr = n & 3;
    for (int i = 0;; ++i) {
        const int idx = i * F.G + ((i & 1) ? (F.G - 1 - F.bid) : F.bid); if (idx >= NB * 4 * 64) break;
        const int tb = 63 - idx / 32, bg = idx % 32, b = bg >> 2, g = bg & 3;
        const int t0 = tb * 64, tq = t0 + 8 * w + qq, hd = 4 * g + rr;
        const size_t tokq = (size_t)b * SEQ + tq;
        const float slope2 = exp2f(-0.5f * (float)(hd + 1)) * LOG2E;
        bf16x8 Qf[4];
#pragma unroll
        for (int ks = 0; ks < 4; ++ks) Qf[ks] = *(const bf16x8*)(NQ + tokq * 1024 + hd * 64 + 16 * ks + 8 * h);
        const float gc = GATES[tokq * 48 + hd * 3 + 0], gsel = GATES[tokq * 48 + hd * 3 + 1], gw = GATES[tokq * 48 + hd * 3 + 2];
        for (int e = lane; e < 8 * 65; e += 64) IMP[(8 * w) * 65 + e] = 0.f;
        f32x16 OF0, OF1;
        TileRegs tr;
        const int ntc = ((t0 + 32) / 16) / 64 + 1;
        const bf16* kcb = KC + (size_t)bg * 256 * 64; const bf16* vcb = VCT + (size_t)bg * 64 * 256;
        float m = NEGBIG, l = 0.f;
#pragma unroll 1
        for (int pass = 0; pass < 2; ++pass) {
            f32x16 O0, O1;
#pragma unroll
            for (int r = 0; r < 16; ++r) { O0[r] = 0.f; O1[r] = 0.f; }
            const float mu = fmaxf(m, -1e20f), invl = l > 0.f ? 1.f / l : 0.f;
            float prev_o3 = 0.f;
            at_load(tr, kcb, 64, vcb, 256, tid);
            __syncthreads();
            at_store(lds, tr, tid);
            __syncthreads();
#pragma unroll 1
            for (int j = 0; j < ntc; ++j) {
                LAS unsigned char* buf = lds + (j & 1) * AT_BUF; LAS unsigned char* nbuf = lds + ((j + 1) & 1) * AT_BUF;
                if (j + 1 < ntc) at_load(tr, kcb + (size_t)(j + 1) * 64 * 64, 64, vcb + (j + 1) * 64, 256, tid);
                f32x16 S0, S1;
#pragma unroll
                for (int r = 0; r < 16; ++r) { S0[r] = 0.f; S1[r] = 0.f; }
                at_qk(buf, Qf, S0, S1, lane);
                const int cbase = tq - 31 - 1024 * j - 64 * h;
#pragma unroll
                for (int r = 0; r < 16; ++r) {
                    const int d0 = cbase - 16 * ((r & 3) + 8 * (r >> 2)), d1 = d0 - 512;
                    S0[r] = d0 >= 0 ? S0[r] - slope2 * (float)d0 : NEGBIG;
                    S1[r] = d1 >= 0 ? S1[r] - slope2 * (float)d1 : NEGBIG;
                }
                if (pass == 0) {
                    float mx = S0[0];
#pragma unroll
                    for (int r = 1; r < 16; ++r) mx = fmaxf(mx, S0[r]);
#pragma unroll
                    for (int r = 0; r < 16; ++r) mx = fmaxf(mx, S1[r]);
                    mx = fmaxf(mx, __shfl_xor(mx, 32));
                    const float mn = fmaxf(m, mx), mu0 = fmaxf(mn, -1e20f);
                    float ps = 0.f;
#pragma unroll
                    for (int r = 0; r < 16; ++r) ps += fast_exp2(S0[r] - mu0) + fast_exp2(S1[r] - mu0);
                    ps += __shfl_xor(ps, 32);
                    l = l * fast_exp2(m - mn) + ps; m = mn;
                } else {
#pragma unroll
                    for (int r = 0; r < 16; ++r) { S0[r] = fast_exp2(S0[r] - mu) * invl; S1[r] = fast_exp2(S1[r] - mu) * invl; }
                    at_pv(buf, S0, S1, O0, O1, lane);
#pragma unroll
                    for (int sub = 0; sub < 2; ++sub)
#pragma unroll
                        for (int u = 0; u < 4; ++u) {
                            float P[4];
#pragma unroll
                            for (int e = 0; e < 4; ++e) { float x = sub == 0 ? S0[4 * u + e] : S1[4 * u + e]; x += __shfl_xor(x, 1); x += __shfl_xor(x, 2); P[e] = x; }
                            const float loc = 2.f * (P[0] + P[1] + P[2]) + P[3];
                            const float o3 = __shfl_xor(P[3], 32);
                            const float cross = h ? o3 : prev_o3;
                            prev_o3 = o3;
                            if (rr == 0) IMP[(8 * w + qq) * 65 + 16 * j + 8 * sub + 2 * u + h] = loc + cross;
                        }
                }
                if (j + 1 < ntc) at_store(nbuf, tr, tid);
                __syncthreads();
            }
            if (pass == 1) {
#pragma unroll
                for (int r = 0; r < 16; ++r) { OACC[r * 512] = O0[r] * gc; OACC[(16 + r) * 512] = O1[r] * gc; }
            }
        }
        LDS_WAIT();
        u64 wun = 0;
#pragma unroll 1
        for (int q = 0; q < 8; ++q) {
            const int tok = 8 * w + q, t = t0 + tok, cur = t >> 6, jb = lane;
            const bool vis = 64 * jb <= t, forced = (jb == 0) || (jb == cur) || (jb == cur - 1);
            const float sc = forced ? 1e9f : (vis ? IMP[tok * 65 + jb] : NEGBIG);
            int rank = 0;
#pragma unroll 8
            for (int ii = 0; ii < 64; ++ii) { const float si = __shfl(sc, ii); rank += (si > sc || (si == sc && ii < jb)) ? 1 : 0; }
            const u64 mk = __ballot(vis && rank < 16);
            if (lane == 0) MASK[tok] = mk;
            wun |= mk;
        }
        if (lane == 0) UNI[w] = wun;
        __syncthreads();
        const u64 mymask = MASK[8 * w + qq];
        u64 umask = 0;
#pragma unroll
        for (int q = 0; q < 8; ++q) umask |= UNI[q];
        { const unsigned lo = __builtin_amdgcn_readfirstlane((unsigned)umask), hi = __builtin_amdgcn_readfirstlane((unsigned)(umask >> 32)); umask = ((u64)hi << 32) | lo; }
        { const unsigned lo = __builtin_amdgcn_readfirstlane((unsigned)wun), hi = __builtin_amdgcn_readfirstlane((unsigned)(wun >> 32)); wun = ((u64)hi << 32) | lo; }
        {
            f32x16 O0, O1;
#pragma unroll
            for (int r = 0; r < 16; ++r) { O0[r] = 0.f; O1[r] = 0.f; }
            m = NEGBIG; l = 0.f;
            const bf16* kb = KVTOK + (size_t)b * SEQ * 1024 + 512 + g * 64; const bf16* vb = KVTR + (size_t)(g * 64) * NTOK + (size_t)b * SEQ;
            u64 rem = umask; int jt = rem ? __builtin_ctzll(rem) : 0; if (rem) rem &= rem - 1;
            const int nts = __builtin_popcountll(umask);
            at_load(tr, kb + (size_t)jt * 64 * 1024, 1024, vb + jt * 64, NTOK, tid);
            __syncthreads();
            at_store(lds, tr, tid);
            __syncthreads();
#pragma unroll 1
            for (int j = 0; j < nts; ++j) {
                LAS unsigned char* buf = lds + (j & 1) * AT_BUF; LAS unsigned char* nbuf = lds + ((j + 1) & 1) * AT_BUF;
                int jn = 0; if (j + 1 < nts) { jn = __builtin_ctzll(rem); rem &= rem - 1; at_load(tr, kb + (size_t)jn * 64 * 1024, 1024, vb + jn * 64, NTOK, tid); }
                if ((wun >> jt) & 1ull) {
                    f32x16 S0, S1;
#pragma unroll
                    for (int r = 0; r < 16; ++r) { S0[r] = 0.f; S1[r] = 0.f; }
                    at_qk(buf, Qf, S0, S1, lane);
                    const bool selme = (mymask >> jt) & 1ull;
                    const int sbase = tq - 64 * jt - 4 * h;
#pragma unroll
                    for (int r = 0; r < 16; ++r) {
                        const int d0 = sbase - ((r & 3) + 8 * (r >> 2)), d1 = d0 - 32;
                        S0[r] = (selme && d0 >= 0) ? S0[r] - slope2 * (float)d0 : NEGBIG;
                        S1[r] = (selme && d1 >= 0) ? S1[r] - slope2 * (float)d1 : NEGBIG;
                    }
                    at_softmax(S0, S1, m, l, O0, O1);
                    at_pv(buf, S0, S1, O0, O1, lane);
                }
                if (j + 1 < nts) at_store(nbuf, tr, tid);
                jt = jn;
                __syncthreads();
            }
            const float sc = l > 0.f ? gsel / l : 0.f;
#pragma unroll
            for (int r = 0; r < 16; ++r) { OACC[r * 512] += O0[r] * sc; OACC[(16 + r) * 512] += O1[r] * sc; }
        }
        {
            f32x16 O0, O1;
#pragma unroll
            for (int r = 0; r < 16; ++r) { O0[r] = 0.f; O1[r] = 0.f; }
            m = NEGBIG; l = 0.f;
            const bf16* kb = KVTOK + (size_t)b * SEQ * 1024 + 768 + g * 64; const bf16* vb = KVTR + (size_t)(256 + g * 64) * NTOK + (size_t)b * SEQ;
            const int jlo = tb >= 8 ? tb - 8 : 0, ntw = tb - jlo + 1;
            at_load(tr, kb + (size_t)jlo * 64 * 1024, 1024, vb + jlo * 64, NTOK, tid);
            __syncthreads();
            at_store(lds, tr, tid);
            __syncthreads();
#pragma unroll 1
            for (int j = 0; j < ntw; ++j) {
                const int jt = jlo + j;
                LAS unsigned char* buf = lds + (j & 1) * AT_BUF; LAS unsigned char* nbuf = lds + ((j + 1) & 1) * AT_BUF;
                if (j + 1 < ntw) at_load(tr, kb + (size_t)(jt + 1) * 64 * 1024, 1024, vb + (jt + 1) * 64, NTOK, tid);
                f32x16 S0, S1;
#pragma unroll
                for (int r = 0; r < 16; ++r) { S0[r] = 0.f; S1[r] = 0.f; }
                at_qk(buf, Qf, S0, S1, lane);
                const int wbase = tq - 64 * jt - 4 * h;
#pragma unroll
                for (int r = 0; r < 16; ++r) {
                    const int d0 = wbase - ((r & 3) + 8 * (r >> 2)), d1 = d0 - 32;
                    S0[r] = (d0 >= 0 && d0 < 512) ? S0[r] - slope2 * (float)d0 : NEGBIG;
                    S1[r] = (d1 >= 0 && d1 < 512) ? S1[r] - slope2 * (float)d1 : NEGBIG;
                }
                at_softmax(S0, S1, m, l, O0, O1);
                at_pv(buf, S0, S1, O0, O1, lane);
                if (j + 1 < ntw) at_store(nbuf, tr, tid);
                __syncthreads();
            }
            const float sc = l > 0.f ? gw / l : 0.f;
#pragma unroll
            for (int r = 0; r < 16; ++r) { OF0[r] = OACC[r * 512] + O0[r] * sc; OF1[r] = OACC[(16 + r) * 512] + O1[r] * sc; }
        }
        bf16* orow = O + tokq * D + hd * 64 + 4 * h;
#pragma unroll
        for (int gq = 0; gq < 4; ++gq) {
            v2u w0; w0.x = cvt_pk_bf16(OF0[4 * gq], OF0[4 * gq + 1]); w0.y = cvt_pk_bf16(OF0[4 * gq + 2], OF0[4 * gq + 3]); *(v2u*)(orow + 8 * gq) = w0;
            v2u w1; w1.x = cvt_pk_bf16(OF1[4 * gq], OF1[4 * gq + 1]); w1.y = cvt_pk_bf16(OF1[4 * gq + 2], OF1[4 * gq + 3]); *(v2u*)(orow + 32 + 8 * gq) = w1;
        }
    }
}

constexpr int N_PHASES = 28;
__global__ void __launch_bounds__(NTHREADS, 2) fwd(Args args) {
    extern __shared__ __attribute__((aligned(16))) unsigned char lds_raw[];
    Frame F;
    F.lds = (LAS unsigned char*)lds_raw;
    F.MISC = (volatile LAS unsigned*)(F.lds + MISC_OFF);
    F.tid = threadIdx.x; F.lane = F.tid & 63; F.wave = __builtin_amdgcn_readfirstlane(F.tid >> 6);
    F.G = gridDim.x; F.bid = blockIdx.x;
    F.ws = args.ws; F.ctl = (unsigned*)(args.ws + WS_CTL); F.out = args.out;
#pragma unroll
    for (int i = 0; i < 26; ++i) F.in[i] = args.in[i];
    if (F.tid < 64) F.MISC[F.tid] = 0u;
    __syncthreads();
    XcdBarrier bar; bar.bar = F.ctl + CW_BAR; bar.x = 0; bar.st = nullptr;
    if (!MK_PER_PHASE) bar = xcd_barrier_post(F.ctl + CW_BAR, F.MISC + 8);
    const int lo = args.ph_lo, hi = args.ph_hi;
#define IN(k) (lo <= (k) && (k) < hi)
#define SEAM(k) do { if (IN(k) && IN((k) + 1)) xcd_barrier(bar); } while (0)
    unsigned char* ws = F.ws;
    bf16* XB = (bf16*)(ws + WS_XB); float* XFA = (float*)(ws + WS_XFA); float* XFB = F.out;
    LAS unsigned char* ring = F.lds + RING_OFF;

    if (IN(0)) { p_prologue(F); }
    SEAM(0);
    if (IN(1)) {
        { PolBf16 P; P.setup(XB, (const bf16*)(ws + WS_W_FQK), NTOK, 2048, D, F.G, F.bid); P.O = (bf16*)(ws + WS_QK); P.ldc = 2048; g8::gemm_phase(ring, P); }
        { PolBf16 P; P.setup((const bf16*)(ws + WS_W_FV), XB, 1024, NTOK, D, F.G, F.bid); P.O = (bf16*)(ws + WS_VT); P.ldc = NTOK; g8::gemm_phase(ring, P); }
        { PolBf16 P; P.setup((const bf16*)(ws + WS_PB), (const bf16*)(ws + WS_W_PP), NTOK, D, PLE, F.G, F.bid); P.O = (bf16*)(ws + WS_PPROJ); P.ldc = D; g8::gemm_phase(ring, P); }
        p_smallproj<16, 0>(F, F.in[0], F.in[2], 3088, 3072, F.in[3], (float*)(ws + WS_LOGF));
    }
    SEAM(1);
    if (IN(2)) { p_scan(F); }
    SEAM(2);
    if (IN(3)) { p_fox_attn(F); }
    SEAM(3);
    if (IN(4)) { PolResid P; P.setup((const bf16*)(ws + WS_O), (const bf16*)(ws + WS_W_FO), NTOK, D, D, F.G, F.bid); P.X = F.in[0]; P.PRE = XFA; g8::gemm_phase(ring, P); }
    SEAM(4);
    if (IN(5)) { p_ln<0, true>(F, XFA, nullptr, F.in[13] + 0 * D, F.in[14] + 0 * D, XB); }
    SEAM(5);
#define MOE_LAYER(L, PH, Xcur, Xoth, LASTLN)                                                                                                                          \
                                                                                                                           \
    if (IN(PH + 0)) {                                                                                                                                               \
        { PolF32 P; P.setup(XB, (const bf16*)(ws + WS_W_RT) + (size_t)(L) * 256 * 1024, NTOK, NE, D, F.G, F.bid); P.O = (float*)(ws + WS_SCORES); P.ldc = NE; g8::gemm_phase(ring, P); } \
        { PolSwigluPlain P; P.setup(XB, (const bf16*)(ws + WS_W_SGU) + (size_t)(L) * 512 * 1024, NTOK, 512, D, F.G, F.bid); P.H = (bf16*)(ws + WS_H); P.rowbase = (size_t)8 * NTOK; g8::gemm_phase(ring, P); } \
    }                                                                                                                                                               \
    SEAM(PH + 0);                                                                                                                                                   \
                                                                                                               \
    if (IN(PH + 1)) {                                                                                                                                               \
        p_route(F, L);                                                                                                                                              \
        { PolResid P; P.setup((const bf16*)(ws + WS_H) + (size_t)8 * NTOK * 256, (const bf16*)(ws + WS_W_SD) + (size_t)(L) * 1024 * 256, NTOK, D, EH, F.G, F.bid); P.X = Xcur; P.PRE = Xoth; g8::gemm_phase(ring, P); } \
    }                                                                                                                                                               \
    SEAM(PH + 1);                                                                                                                                                   \
                                                                                                                                           \
    if (IN(PH + 2)) {                                                                                                                                               \
        const int nu = build_units(F, L, 2);                                                                                                                        \
        PolSwigluGrouped P; P.A = XB; P.Wb = (const bf16*)(ws + WS_W_EGU) + (size_t)(L) * 256 * 512 * 1024; P.nt = D / 64; P.kstepA = 128; P.kstepB = 128; P.pitchA = D * 2; P.pitchB = D * 2; P.nu = nu; \
        P.wstride_e = (size_t)512 * 1024 * 2; P.wstride_pn = (size_t)256 * 1024 * 2; P.desc = (const LAS int*)(F.lds + DESC_OFF); P.rows = (const LAS int*)(F.lds + ROWS_OFF); P.H = (bf16*)(ws + WS_H); \
        g8::gemm_phase(ring, P);                                                                                                                                    \
    }                                                                                                                                                               \
    SEAM(PH + 2);                                                                                                                                                   \
                                                                                                                                              \
    if (IN(PH + 3)) {                                                                                                                                               \
        const int nu = build_units(F, L, 4);                                                                                                                        \
        PolDownGrouped P; P.A = (const bf16*)(ws + WS_H); P.Wb = (const bf16*)(ws + WS_W_ED) + (size_t)(L) * 256 * 1024 * 256; P.nt = EH / 64; P.kstepA = 128; P.kstepB = 128; P.pitchA = EH * 2; P.pitchB = EH * 2; P.nu = nu; \
        P.wstride_e = (size_t)1024 * 256 * 2; P.wstride_pn = (size_t)256 * 256 * 2; P.desc = (const LAS int*)(F.lds + DESC_OFF); P.rows = (const LAS int*)(F.lds + ROWS_OFF); P.Y = (bf16*)(ws + WS_Y); P.wts = (const float*)(ws + WS_WTS); \
        g8::gemm_phase(ring, P);                                                                                                                                    \
    }                                                                                                                                                               \
    SEAM(PH + 3);                                                                                                                                                   \
                                                                                                                                 \
    if (IN(PH + 4)) { p_ln<1, true>(F, Xoth, (const bf16*)(ws + WS_Y), F.in[13] + ((L) * 3 + 1) * D, F.in[14] + ((L) * 3 + 1) * D, XB); }                            \
    SEAM(PH + 4);                                                                                                                                                   \
                                                                                                              \
    if (IN(PH + 5)) { PolPle P; P.setup(XB, (const bf16*)(ws + WS_W_PG) + (size_t)(L) * 1024 * 1024, NTOK, D, D, F.G, F.bid); P.X = Xoth; P.PRE = Xcur; P.bias = F.in[25] + (L) * D; P.PP = (const bf16*)(ws + WS_PPROJ); g8::gemm_phase(ring, P); } \
    SEAM(PH + 5);                                                                                                                                                   \
                                                                                                                                           \
    if (IN(PH + 6)) { p_ln<0, !(LASTLN)>(F, Xcur, nullptr, F.in[13] + ((L) * 3 + 2) * D, F.in[14] + ((L) * 3 + 2) * D, XB); }

    MOE_LAYER(0, 6, XFA, XFB, false)
    SEAM(12);
    if (IN(13)) {
        { PolBf16 P; P.setup(XB, (const bf16*)(ws + WS_W_KVTOK), NTOK, 1024, D, F.G, F.bid); P.O = (bf16*)(ws + WS_QK); P.ldc = 1024; g8::gemm_phase(ring, P); }
        { PolBf16 P; P.setup(XB, (const bf16*)(ws + WS_W_NQ), NTOK, 1024, D, F.G, F.bid); P.O = (bf16*)(ws + WS_QK + 64 * MiB); P.ldc = 1024; g8::gemm_phase(ring, P); }
        { PolBf16 P; P.setup((const bf16*)(ws + WS_W_KVTR), XB, 512, NTOK, D, F.G, F.bid); P.O = (bf16*)(ws + WS_VT); P.ldc = NTOK; g8::gemm_phase(ring, P); }
        { PolBf16 P; P.setup((const bf16*)(ws + WS_PB) + (size_t)NTOK * PLE, (const bf16*)(ws + WS_W_PP) + (size_t)1024 * 256, NTOK, D, PLE, F.G, F.bid); P.O = (bf16*)(ws + WS_PPROJ); P.ldc = D; g8::gemm_phase(ring, P); }
        p_smallproj<48, 1>(F, XFA, F.in[10], 1072, 1024, F.in[11], (float*)(ws + WS_GATES));
    }
    SEAM(13);
    if (IN(14)) { PolCmp1 P; P.A = (const bf16*)(ws + WS_QK); P.Bt = (const bf16*)(ws + WS_W_C1); P.nt = 32; P.kstepA = 2048; P.kstepB = 128; P.pitchB = 4096; P.S.init(64, 1, F.G, F.bid); P.b1p = (const float*)(ws + WS_B1P); P.HMID = (bf16*)(ws + WS_HMID); g8::gemm_phase(ring, P); }
    SEAM(14);
    if (IN(15)) { p_cmp2(F); }
    SEAM(15);
    if (IN(16)) { p_nsa_attn(F); }
    SEAM(16);
    if (IN(17)) { PolResid P; P.setup((const bf16*)(ws + WS_O), (const bf16*)(ws + WS_W_NO), NTOK, D, D, F.G, F.bid); P.X = XFA; P.PRE = XFB; g8::gemm_phase(ring, P); }
    SEAM(17);
    if (IN(18)) { p_ln<0, true>(F, XFB, nullptr, F.in[13] + 3 * D, F.in[14] + 3 * D, XB); }
    SEAM(18);
    MOE_LAYER(1, 19, XFB, XFA, true)
#undef IN
#undef SEAM
}

extern "C" void kernel_launch(void* const* d_in, const int* in_sizes, int n_in, void* d_out, int out_size, void* d_ws, size_t ws_size, hipStream_t stream) {
    static int grid = 0;
    if (grid == 0) {
        if (n_in != 26 || out_size != NTOK * D || ws_size < WS_END) { fprintf(stderr, "kernel_launch: unexpected problem (n_in %d out %d ws %zu need %zu)\n", n_in, out_size, ws_size, (size_t)WS_END); grid = -1; return; }
        int dev = 0, cus = 0, per_cu = 0;
        if (hipGetDevice(&dev) != hipSuccess || hipDeviceGetAttribute(&cus, hipDeviceAttributeMultiprocessorCount, dev) != hipSuccess) { grid = -1; return; }
        if (hipFuncSetAttribute((const void*)fwd, hipFuncAttributeMaxDynamicSharedMemorySize, LDS_BYTES) != hipSuccess) { fprintf(stderr, "kernel_launch: hipFuncSetAttribute failed\n"); grid = -1; return; }
        if (hipOccupancyMaxActiveBlocksPerMultiprocessor(&per_cu, (const void*)fwd, NTHREADS, LDS_BYTES) != hipSuccess || per_cu < 1) fprintf(stderr, "kernel_launch: occupancy query reports %d\n", per_cu);
        (void)hipGetLastError();
        grid = cus;
    }
    if (grid < 0) return;
    if (hipMemsetAsync((char*)d_ws + WS_CTL, 0, CTL_ZERO_BYTES, stream) != hipSuccess) return;
    Args a{};
    for (int i = 0; i < 26; ++i) a.in[i] = (const float*)d_in[i];
    a.out = (float*)d_out; a.ws = (unsigned char*)d_ws;
#if MK_PER_PHASE
    for (int ph = 0; ph < 26; ++ph) { a.ph_lo = ph; a.ph_hi = ph + 1; hipLaunchKernelGGL(fwd, dim3(grid), dim3(NTHREADS), LDS_BYTES, stream, a); }
#else
    a.ph_lo = 0; a.ph_hi = 26;
    hipLaunchKernelGGL(fwd, dim3(grid), dim3(NTHREADS), LDS_BYTES, stream, a);
#endif
}
```

```cpp
#include <hip/hip_runtime.h>
#include <cstdio>
#include <cstdint>

#ifndef PROBE_REP
#define PROBE_REP 0ull
#endif
#ifndef MK_PER_PHASE
#define MK_PER_PHASE 0
#endif

#define GAS __attribute__((address_space(1)))
#define LAS __attribute__((address_space(3)))
typedef unsigned short bf16;
typedef unsigned v4u __attribute__((ext_vector_type(4)));
typedef unsigned v2u __attribute__((ext_vector_type(2)));
typedef float f32x2 __attribute__((ext_vector_type(2)));
typedef float f32x4 __attribute__((ext_vector_type(4)));
typedef float f32x16 __attribute__((ext_vector_type(16)));
typedef short bf16x8 __attribute__((ext_vector_type(8)));
typedef short bf16x4 __attribute__((ext_vector_type(4)));
typedef unsigned long long u64;

constexpr int NB = 8, SEQ = 4096, D = 1024, NTOK = NB * SEQ, NH = 16, HD = 64;
constexpr int NE = 256, TOPK = 8, EH = 256, PLE = 256;
constexpr int NWAVES = 8, NTHREADS = NWAVES * 64;
constexpr float LN_EPS = 1e-5f;
constexpr float ALPHA = 1.41421356237309515f;
constexpr float LOG2E = 1.44269504088896341f;
constexpr float QSCALE = 0.125f * LOG2E;
constexpr float NEGBIG = -1e30f;

constexpr size_t MiB = 1u << 20;
constexpr size_t WS_CTL = 0, CTL_ZERO_BYTES = 1 * MiB;
constexpr size_t WS_W_FQK = 1 * MiB;
constexpr size_t WS_W_FV = 5 * MiB;
constexpr size_t WS_W_FO = 7 * MiB;
constexpr size_t WS_W_KVTOK = 9 * MiB;
constexpr size_t WS_W_KVTR = 11 * MiB;
constexpr size_t WS_W_NQ = 12 * MiB;
constexpr size_t WS_W_NO = 14 * MiB;
constexpr size_t WS_W_RT = 16 * MiB;
constexpr size_t WS_W_SGU = 17 * MiB;
constexpr size_t WS_W_SD = 19 * MiB;
constexpr size_t WS_W_PP = 20 * MiB;
constexpr size_t WS_W_PG = 21 * MiB;
constexpr size_t WS_W_C1 = 25 * MiB;
constexpr size_t WS_B1P = 27 * MiB;
constexpr size_t WS_W_FG = 27 * MiB + 4096;
constexpr size_t WS_W_NG = 28 * MiB + 131072;
constexpr size_t WS_KC = 27 * MiB + 65536;
constexpr size_t WS_VCT = 29 * MiB;
constexpr size_t WS_HMID = 30 * MiB;
constexpr size_t WS_W_EGU = 34 * MiB;
constexpr size_t WS_W_ED = 546 * MiB;
constexpr size_t WS_XB = 802 * MiB;
constexpr size_t WS_XFA = 866 * MiB;
constexpr size_t WS_PB = 994 * MiB;
constexpr size_t WS_PPROJ = 1026 * MiB;
constexpr size_t WS_QK = 1090 * MiB;
constexpr size_t WS_VT = 1218 * MiB;
constexpr size_t WS_H = WS_QK;
constexpr size_t WS_O = 1282 * MiB;
constexpr size_t WS_LOGF = 1346 * MiB;
constexpr size_t WS_C2 = 1348 * MiB;
constexpr size_t WS_GATES = 1350 * MiB;
constexpr size_t WS_SCORES = 1356 * MiB;
constexpr size_t WS_WTS = 1388 * MiB;
constexpr size_t WS_LISTS = 1389 * MiB;
constexpr size_t WS_Y = 1421 * MiB;
constexpr size_t WS_END = 1933 * MiB;
static_assert(WS_H + (size_t)9 * NTOK * 256 * 2 <= WS_O, "H overlay");
constexpr int CW_TMO = 0;
constexpr int CW_BAR = 4096;
constexpr int CW_CNT = 16384;
constexpr int CW_KMAX = 20480;

constexpr int RING_OFF = 0, RING_BYTES = 131072;
constexpr int MISC_OFF = RING_BYTES;
constexpr int TBL_OFF = RING_BYTES + 1024;
constexpr int DESC_OFF = TBL_OFF + 3072;
constexpr int ROWS_OFF = DESC_OFF + 512;
constexpr int MAXU = 26;
constexpr int LDS_BYTES = ROWS_OFF + MAXU * 1024;
static_assert(LDS_BYTES <= 163840, "LDS");

#define RLX_AGENT __ATOMIC_RELAXED, __HIP_MEMORY_SCOPE_AGENT
#define LDS_WAIT() asm volatile("s_waitcnt lgkmcnt(0)" ::: "memory")
#define VM_WAIT() asm volatile("s_waitcnt vmcnt(0)" ::: "memory")
__device__ __forceinline__ unsigned f2bf(float f) { unsigned u = __builtin_bit_cast(unsigned, f); return (u + 0x7fffu + ((u >> 16) & 1u)) >> 16; }
__device__ __forceinline__ unsigned pk2(float lo, float hi) { return f2bf(lo) | (f2bf(hi) << 16); }
__device__ __forceinline__ unsigned cvt_pk_bf16(float lo, float hi) { unsigned r; asm volatile("v_cvt_pk_bf16_f32 %0, %1, %2" : "=v"(r) : "v"(lo), "v"(hi)); return r; }
__device__ __forceinline__ float bf_lo(unsigned u) { return __builtin_bit_cast(float, u << 16); }
__device__ __forceinline__ float bf_hi(unsigned u) { return __builtin_bit_cast(float, u & 0xffff0000u); }
__device__ __forceinline__ float fast_exp2(float x) { return __builtin_amdgcn_exp2f(x); }
__device__ __forceinline__ float sigmoidf_(float x) { return 1.f / (1.f + __expf(-x)); }

__device__ __forceinline__ float xhalf_other(float v, int h) { return __shfl_xor(v, 32); }
__device__ __forceinline__ float xhalf_max(float v) { return fmaxf(v, __shfl_xor(v, 32)); }
__device__ __forceinline__ float xhalf_sum(float v) { return v + __shfl_xor(v, 32); }

#define XB_TMO      128
#define XB_XCNT(j)  (256  + 64 * (j))
#define XB_XSUB(j)  (1280 + 64 * (j))
#define XB_XGEN(j)  (2304 + 64 * (j))
#define XB_TOP      3328
#define XB_TOPGEN   3392
#define XCD_BAR_WORDS 3456
#define XB_SPIN_CAP (1u << 22)

__device__ __forceinline__ unsigned xb_ld(unsigned* p)              { return __hip_atomic_load(p, __ATOMIC_RELAXED, __HIP_MEMORY_SCOPE_AGENT); }
__device__ __forceinline__ unsigned xb_add(unsigned* p, unsigned v) { return __hip_atomic_fetch_add(p, v, __ATOMIC_RELAXED, __HIP_MEMORY_SCOPE_AGENT); }
__device__ __forceinline__ unsigned xb_xcc_id() { return (unsigned)__builtin_amdgcn_s_getreg((3 << 11) | 20) & 0xFu; }
#define XB_SPIN(cond, bar) do { unsigned _sp = 0; while (cond) { __builtin_amdgcn_s_sleep(1); \
    if ((++_sp & 255u) == 0u) { if (xb_ld(&(bar)[XB_TMO])) break; if (_sp > XB_SPIN_CAP) { atomicAdd(&(bar)[XB_TMO], 1u); break; } } } } while (0)

struct XcdBarrier { unsigned* bar; unsigned x; volatile LAS unsigned* st; };

__device__ __forceinline__ XcdBarrier xcd_barrier_post(unsigned* bar, volatile LAS unsigned* st) {
    XcdBarrier b; b.bar = bar; b.x = xb_xcc_id(); b.st = st;
    if (threadIdx.x == 0) (void)xb_add(&bar[XB_XCNT(b.x)], 1u);
    return b;
}
__device__ __forceinline__ void xcd_barrier_complete(unsigned* bar, unsigned x, unsigned& nloc, unsigned& nx) {
    const unsigned G = gridDim.x * gridDim.y * gridDim.z;
    unsigned sum, cnt, mine, sp = 0u;
    for (;;) {
        sum = 0u; cnt = 0u; mine = 0u;
#pragma unroll
        for (unsigned j = 0; j < 16; ++j) { const unsigned c = xb_ld(&bar[XB_XCNT(j)]); sum += c; cnt += (c > 0u) ? 1u : 0u; mine = (j == x) ? c : mine; }
        if (sum == G) break;
        __builtin_amdgcn_s_sleep(1);
        if ((++sp & 255u) == 0u) { if (xb_ld(&bar[XB_TMO])) break; if (sp > XB_SPIN_CAP) { atomicAdd(&bar[XB_TMO], 1u); break; } }
    }
    nloc = mine > 0u ? mine : 1u; nx = cnt > 0u ? cnt : 1u;
}
__device__ __forceinline__ void xcd_barrier(const XcdBarrier& b) {
    asm volatile("s_waitcnt vmcnt(0)" ::: "memory");
    __syncthreads();
    if (threadIdx.x == 0) {
        unsigned* bar = b.bar;
        __builtin_amdgcn_s_waitcnt(0);
        unsigned nloc = b.st[0], nx = b.st[1];
        if (nloc == 0u) { xcd_barrier_complete(bar, b.x, nloc, nx); b.st[0] = nloc; b.st[1] = nx; }
        const unsigned old = xb_add(&bar[XB_XSUB(b.x)], 1u);
        const unsigned gen = old / nloc;
        if (old + 1u == (gen + 1u) * nloc) {
            __builtin_amdgcn_fence(__ATOMIC_RELEASE, "agent");
            asm volatile("s_waitcnt vmcnt(0)" ::: "memory");
            const unsigned og = xb_add(&bar[XB_TOP], 1u);
            const unsigned tg = og / nx;
            if (og + 1u == (tg + 1u) * nx) xb_add(&bar[XB_TOPGEN], 1u);
            else XB_SPIN(xb_ld(&bar[XB_TOPGEN]) == tg, bar);
            __builtin_amdgcn_fence(__ATOMIC_ACQUIRE, "agent");
            xb_add(&bar[XB_XGEN(b.x)], 1u);
            asm volatile("s_waitcnt vmcnt(0)" ::: "memory");
        } else {
            XB_SPIN(xb_ld(&bar[XB_XGEN(b.x)]) == gen, bar);
            __builtin_amdgcn_fence(__ATOMIC_ACQUIRE, "agent");
            asm volatile("s_waitcnt vmcnt(0)" ::: "memory");
        }
    }
    __syncthreads();
}

namespace g8 {
constexpr int BM = 256, BK = 64, HALF = 128, HTB = HALF * BK * 2, STAGE_BYTES = 8 * HTB, NXCD = 8, WGM = 8;
__host__ __device__ __forceinline__ int lds_byte(int r, int c) { const int st = (r >> 4) * 2 + (c >> 5), rr = r & 15, cc = c & 31, ob = rr * 64 + cc * 2; return st * 1024 + (ob ^ (((ob >> 9) & 1) << 5)); }
__host__ __device__ __forceinline__ void stage_rc(int b, int& R, int& C) { const int st = b / 1024, sb = b % 1024, swz = sb ^ (((sb >> 9) & 1) << 5); R = (st >> 1) * 16 + swz / 64; C = (st & 1) * 32 + (swz % 64) / 2; }
__host__ __device__ __forceinline__ int perm32(int rho) { const int n = rho >> 4, i = rho & 15; return 8 * (i >> 2) + 4 * n + (i & 3); }

struct GUnit { int pm, pn, e, cnt; };

struct StaticOrder {
    int nM, nN, nwg, G, c;
    __device__ void init(int nM_, int nN_, int G_, int c_) { nM = nM_; nN = nN_; nwg = nM * nN; G = G_; c = c_; }
    __device__ bool next(int i, GUnit& u) const {
        const long L = (long)i * G + c; if (L >= nwg) return false;
        int wgid = (int)L; { const int q = nwg / NXCD, r = nwg % NXCD, xcd = wgid % NXCD, off = wgid / NXCD; wgid = (xcd < r ? xcd * (q + 1) : r * (q + 1) + (xcd - r) * q) + off; }
        const int nig = WGM * nN, gid = wgid / nig, fm = gid * WGM, gsz = (nM - fm) < WGM ? (nM - fm) : WGM;
        u.pm = fm + ((wgid % nig) % gsz); u.pn = (wgid % nig) / gsz; u.e = 0; u.cnt = 256; return true;
    }
};

typedef f32x4 Acc[2][2][4][2];

template <class P>
__device__ __forceinline__ void gemm_phase(LAS unsigned char* lds, const P& p) {
    const int tid = threadIdx.x, wid = __builtin_amdgcn_readfirstlane(tid >> 6), lane = tid & 63, wr = wid >> 2, wc = wid & 3, fr = lane & 15, fq = lane >> 4;
    const int nt = p.nt;
    int Rr[2], Cc[2]; unsigned voffB[2];
#pragma unroll
    for (int i = 0; i < 2; ++i) { int R, C; stage_rc(tid * 16 + i * 8192, R, C); Rr[i] = R; Cc[i] = C; const int Rb = (R & ~31) + perm32(R & 31);
        voffB[i] = (unsigned)Rb * (unsigned)p.pitchB + (unsigned)C * 2u; }
    const size_t kstepA = p.kstepA, kstepB = p.kstepB;
    const size_t hstepB = (size_t)HALF * p.pitchB;
    const unsigned ldsw = (unsigned)wid * 1024u;
    const int aoff = lds_byte(wr * 64 + fr, fq * 8), boff = lds_byte(wc * 32 + fr, fq * 8);
#define G8_SA(b, h) (((b) * 2 + (h)) * HTB)
#define G8_SB(b, h) ((4 + (b) * 2 + (h)) * HTB)
#define G8_STAGE(bufoff, gbase, voff) do { _Pragma("unroll") for (int _i = 0; _i < 2; ++_i) \
        __builtin_amdgcn_global_load_lds((const unsigned*)((const char*)(gbase) + (voff)[_i]), (LAS unsigned*)(lds + (bufoff) + ldsw + _i * 8192), 16, 0, 0); } while (0)
#define G8_LDA(dst, b, h) do { _Pragma("unroll") for (int m = 0; m < 4; ++m) _Pragma("unroll") for (int k = 0; k < 2; ++k) dst[m][k] = *(const LAS bf16x8*)(lds + G8_SA(b, h) + aoff + m * 2048 + k * 1024); } while (0)
#define G8_LDB(dst, b, h) do { _Pragma("unroll") for (int n = 0; n < 2; ++n) _Pragma("unroll") for (int k = 0; k < 2; ++k) dst[n][k] = *(const LAS bf16x8*)(lds + G8_SB(b, h) + boff + n * 2048 + k * 1024); } while (0)
#define G8_MMA(ai, bj, At, Bt) do { __builtin_amdgcn_s_setprio(1); _Pragma("unroll") for (int m = 0; m < 4; ++m) _Pragma("unroll") for (int n = 0; n < 2; ++n) _Pragma("unroll") for (int k = 0; k < 2; ++k) \
        acc[ai][bj][m][n] = __builtin_amdgcn_mfma_f32_16x16x32_bf16(Bt[n][k], At[m][k], acc[ai][bj][m][n], 0, 0, 0); __builtin_amdgcn_s_setprio(0); } while (0)
#define G8_WAIT_V(n) asm volatile("s_waitcnt vmcnt(" #n ")" ::: "memory")
#define G8_WAIT_L(n) asm volatile("s_waitcnt lgkmcnt(" #n ")" ::: "memory")
#define G8_BAR __builtin_amdgcn_s_barrier()
#define G8_SCHED __builtin_amdgcn_sched_barrier(0)
#define G8_ZERO_ACC() do { _Pragma("unroll") for (int a = 0; a < 2; ++a) _Pragma("unroll") for (int b = 0; b < 2; ++b) _Pragma("unroll") for (int m = 0; m < 4; ++m) _Pragma("unroll") for (int n = 0; n < 2; ++n) acc[a][b][m][n] = (f32x4){0.f, 0.f, 0.f, 0.f}; } while (0)
#define G8_AOFF(dst, u) do { _Pragma("unroll") for (int _h = 0; _h < 2; ++_h) _Pragma("unroll") for (int _i = 0; _i < 2; ++_i) dst[_h][_i] = p.arow(u, _h * HALF + Rr[_i]) + (unsigned)Cc[_i] * 2u; } while (0)
    GUnit cur, nxt; int ui = 0;
    if (!p.next(0, cur)) return;
    Acc acc; G8_ZERO_ACC();
    bf16x8 At[4][2], B0[2][2], B1[2][2];
    unsigned vAc[2][2], vAn[2][2];
    G8_AOFF(vAc, cur);
    const char* const pA = (const char*)p.A;
    const char* cB = p.bptr(cur);
    G8_STAGE(G8_SB(0, 0), cB, voffB); G8_STAGE(G8_SB(0, 1), cB + hstepB, voffB); G8_STAGE(G8_SA(0, 0), pA, vAc[0]); G8_STAGE(G8_SA(0, 1), pA, vAc[1]);
    if (wr == 1) G8_BAR;
    G8_WAIT_V(2); G8_BAR;
    G8_STAGE(G8_SB(1, 0), cB + kstepB, voffB); G8_STAGE(G8_SA(1, 0), pA + kstepA, vAc[0]); G8_STAGE(G8_SB(1, 1), cB + hstepB + kstepB, voffB);
    G8_WAIT_V(6); G8_BAR;
    for (;;) {
        const bool has_next = p.next(ui + 1, nxt);
        if (has_next) { G8_AOFF(vAn, nxt); } else {
#pragma unroll
            for (int h = 0; h < 2; ++h)
#pragma unroll
                for (int i = 0; i < 2; ++i) vAn[h][i] = vAc[h][i]; }
        const char* nB = has_next ? p.bptr(nxt) : cB;
        for (int t = 0; t < nt; t += 2) {
            const bool last = (t == nt - 2);
            const char* a1 = pA + (size_t)(t + 1) * kstepA;
            const char* a2 = last ? pA : pA + (size_t)(t + 2) * kstepA; const char* b2 = last ? nB : cB + (size_t)(t + 2) * kstepB;
            const char* a3 = a2 + kstepA; const char* b3 = b2 + kstepB;
            unsigned w0[2], w1[2];
            w0[0] = last ? vAn[0][0] : vAc[0][0]; w0[1] = last ? vAn[0][1] : vAc[0][1]; w1[0] = last ? vAn[1][0] : vAc[1][0]; w1[1] = last ? vAn[1][1] : vAc[1][1];
            G8_LDB(B0, 0, 0); G8_LDB(B1, 0, 1); G8_SCHED; G8_LDA(At, 0, 0); G8_STAGE(G8_SA(1, 1), a1, vAc[1]);
            G8_WAIT_V(8); G8_WAIT_L(0); G8_BAR; G8_MMA(0, 0, At, B0); G8_MMA(0, 1, At, B1); G8_BAR; G8_SCHED;
            G8_LDA(At, 0, 1); G8_STAGE(G8_SB(0, 0), b2, voffB); G8_STAGE(G8_SB(0, 1), b2 + hstepB, voffB); G8_STAGE(G8_SA(0, 0), a2, w0);
            G8_WAIT_V(8); G8_WAIT_L(0); G8_BAR; G8_MMA(1, 0, At, B0); G8_MMA(1, 1, At, B1); G8_BAR; G8_SCHED;
            G8_LDB(B0, 1, 0); G8_LDB(B1, 1, 1); G8_SCHED; G8_LDA(At, 1, 0); G8_STAGE(G8_SA(0, 1), a2, w1);
            G8_WAIT_V(8); G8_WAIT_L(0); G8_BAR; G8_MMA(0, 0, At, B0); G8_MMA(0, 1, At, B1); G8_BAR; G8_SCHED;
            G8_LDA(At, 1, 1); G8_STAGE(G8_SB(1, 0), b3, voffB); G8_STAGE(G8_SB(1, 1), b3 + hstepB, voffB); G8_STAGE(G8_SA(1, 0), a3, w0);
            G8_WAIT_V(8); G8_WAIT_L(0); G8_BAR; G8_MMA(1, 0, At, B0); G8_MMA(1, 1, At, B1); G8_BAR; G8_SCHED;
        }
        if (wr == 0) G8_BAR;
        p.epi(acc, cur, wr, wc, fr, fq);
        if (!has_next) break;
        G8_ZERO_ACC();
        cur = nxt; cB = nB; ++ui;
#pragma unroll
        for (int h = 0; h < 2; ++h)
#pragma unroll
            for (int i = 0; i < 2; ++i) vAc[h][i] = vAn[h][i];
        if (wr == 1) G8_BAR;
    }
    G8_WAIT_V(0);
    G8_BAR;
#undef G8_SA
#undef G8_SB
#undef G8_STAGE
#undef G8_LDA
#undef G8_LDB
#undef G8_MMA
#undef G8_WAIT_V
#undef G8_WAIT_L
#undef G8_BAR
#undef G8_SCHED
#undef G8_ZERO_ACC
#undef G8_AOFF
}
}
using g8::GUnit; using g8::Acc;

struct Frame {
    LAS unsigned char* lds;
    volatile LAS unsigned* MISC;
    unsigned* ctl;
    unsigned char* ws;
    const float* in[26];
    float* out;
    int tid, lane, wave, G, bid;
};
struct Args { const float* in[26]; float* out; unsigned char* ws; int ph_lo, ph_hi; };

#define EPI_FOR_ROWS(ai, m) _Pragma("unroll") for (int ai = 0; ai < 2; ++ai) _Pragma("unroll") for (int m = 0; m < 4; ++m)

struct PlainBase {
    const bf16* A; const bf16* Bt; int nt; size_t kstepA, kstepB; unsigned pitchA, pitchB; g8::StaticOrder S;
    __device__ __forceinline__ void setup(const bf16* A_, const bf16* Bt_, int M, int N, int K, int G, int c) { A = A_; Bt = Bt_; nt = K / 64; kstepA = 128; kstepB = 128; pitchA = (unsigned)K * 2u; pitchB = (unsigned)K * 2u; S.init(M / 256, N / 256, G, c); }
    __device__ __forceinline__ bool next(int i, GUnit& u) const { return S.next(i, u); }
    __device__ __forceinline__ unsigned arow(const GUnit& u, int row) const { return (unsigned)(u.pm * 256 + row) * pitchA; }
    __device__ __forceinline__ const char* bptr(const GUnit& u) const { return (const char*)Bt + (size_t)u.pn * 256 * pitchB; }
};
struct PolBf16 : PlainBase {
    bf16* O; int ldc;
    __device__ __forceinline__ void epi(const Acc& acc, const GUnit& u, int wr, int wc, int fr, int fq) const {
        EPI_FOR_ROWS(ai, m) { const int row = u.pm * 256 + ai * 128 + wr * 64 + m * 16 + fr;
#pragma unroll
            for (int bj = 0; bj < 2; ++bj) { const int col = u.pn * 256 + bj * 128 + wc * 32 + fq * 8; const f32x4 v0 = acc[ai][bj][m][0], v1 = acc[ai][bj][m][1];
                v4u w; w.x = cvt_pk_bf16(v0[0], v0[1]); w.y = cvt_pk_bf16(v0[2], v0[3]); w.z = cvt_pk_bf16(v1[0], v1[1]); w.w = cvt_pk_bf16(v1[2], v1[3]);
                *(v4u*)(O + (size_t)row * ldc + col) = w; } }
    }
};
struct PolF32 : PlainBase {
    float* O; int ldc;
    __device__ __forceinline__ void epi(const Acc& acc, const GUnit& u, int wr, int wc, int fr, int fq) const {
        EPI_FOR_ROWS(ai, m) { const int row = u.pm * 256 + ai * 128 + wr * 64 + m * 16 + fr;
#pragma unroll
            for (int bj = 0; bj < 2; ++bj) { const int col = u.pn * 256 + bj * 128 + wc * 32 + fq * 8; float* o = O + (size_t)row * ldc + col;
                *(f32x4*)o = acc[ai][bj][m][0]; *(f32x4*)(o + 4) = acc[ai][bj][m][1]; } }
    }
};
struct PolResid : PlainBase {
    const float* X; float* PRE;
    __device__ __forceinline__ void epi(const Acc& acc, const GUnit& u, int wr, int wc, int fr, int fq) const {
        EPI_FOR_ROWS(ai, m) { const int row = u.pm * 256 + ai * 128 + wr * 64 + m * 16 + fr;
#pragma unroll
            for (int bj = 0; bj < 2; ++bj) { const int col = u.pn * 256 + bj * 128 + wc * 32 + fq * 8; const size_t o = (size_t)row * D + col;
                const f32x4 x0 = *(const f32x4*)(X + o), x1 = *(const f32x4*)(X + o + 4);
                *(f32x4*)(PRE + o) = x0 * ALPHA + acc[ai][bj][m][0]; *(f32x4*)(PRE + o + 4) = x1 * ALPHA + acc[ai][bj][m][1]; } }
    }
};
struct PolPle : PlainBase {
    const float* X; float* PRE; const float* bias; const bf16* PP;
    __device__ __forceinline__ void epi(const Acc& acc, const GUnit& u, int wr, int wc, int fr, int fq) const {
        EPI_FOR_ROWS(ai, m) { const int row = u.pm * 256 + ai * 128 + wr * 64 + m * 16 + fr;
#pragma unroll
            for (int bj = 0; bj < 2; ++bj) { const int col = u.pn * 256 + bj * 128 + wc * 32 + fq * 8; const size_t o = (size_t)row * D + col;
                const f32x4 x0 = *(const f32x4*)(X + o), x1 = *(const f32x4*)(X + o + 4);
                const f32x4 b0 = *(const f32x4*)(bias + col), b1 = *(const f32x4*)(bias + col + 4);
                const v4u pp = *(const v4u*)(PP + o);
                const f32x4 a0 = acc[ai][bj][m][0] + b0, a1 = acc[ai][bj][m][1] + b1;
                f32x4 r0, r1;
                r0[0] = x0[0] * ALPHA + sigmoidf_(a0[0]) * bf_lo(pp.x); r0[1] = x0[1] * ALPHA + sigmoidf_(a0[1]) * bf_hi(pp.x);
                r0[2] = x0[2] * ALPHA + sigmoidf_(a0[2]) * bf_lo(pp.y); r0[3] = x0[3] * ALPHA + sigmoidf_(a0[3]) * bf_hi(pp.y);
                r1[0] = x1[0] * ALPHA + sigmoidf_(a1[0]) * bf_lo(pp.z); r1[1] = x1[1] * ALPHA + sigmoidf_(a1[1]) * bf_hi(pp.z);
                r1[2] = x1[2] * ALPHA + sigmoidf_(a1[2]) * bf_lo(pp.w); r1[3] = x1[3] * ALPHA + sigmoidf_(a1[3]) * bf_hi(pp.w);
                *(f32x4*)(PRE + o) = r0; *(f32x4*)(PRE + o + 4) = r1; } }
    }
};
__device__ __forceinline__ float silu_(float x) { return x / (1.f + __expf(-x)); }
struct PolSwigluPlain : PlainBase {
    bf16* H; size_t rowbase;
    __device__ __forceinline__ void epi(const Acc& acc, const GUnit& u, int wr, int wc, int fr, int fq) const {
        EPI_FOR_ROWS(ai, m) { const int row = u.pm * 256 + ai * 128 + wr * 64 + m * 16 + fr; const int col = u.pn * 128 + wc * 32 + fq * 8;
            const f32x4 g0 = acc[ai][0][m][0], g1 = acc[ai][0][m][1], u0 = acc[ai][1][m][0], u1 = acc[ai][1][m][1];
            v4u w; w.x = cvt_pk_bf16(silu_(g0[0]) * u0[0], silu_(g0[1]) * u0[1]); w.y = cvt_pk_bf16(silu_(g0[2]) * u0[2], silu_(g0[3]) * u0[3]);
            w.z = cvt_pk_bf16(silu_(g1[0]) * u1[0], silu_(g1[1]) * u1[1]); w.w = cvt_pk_bf16(silu_(g1[2]) * u1[2], silu_(g1[3]) * u1[3]);
            *(v4u*)(H + (rowbase + row) * 256 + col) = w; }
    }
};
__device__ __forceinline__ float gelu_tanh_(float x) { const float u = 0.7978845608028654f * (x + 0.044715f * x * x * x); const float e = __expf(2.f * u); const float t = 1.f - 2.f / (e + 1.f); return 0.5f * x * (1.f + t); }
struct PolCmp1 {
    const bf16* A; const bf16* Bt; int nt; size_t kstepA, kstepB; unsigned pitchB; g8::StaticOrder S; const float* b1p; bf16* HMID;
    __device__ __forceinline__ bool next(int i, GUnit& u) const { return S.next(i, u); }
    __device__ __forceinline__ unsigned arow(const GUnit& u, int row) const {
        const int r = u.pm * 256 + row, j = r >> 13, rr = r & 8191, bg = rr >> 8, c = rr & 255, b = bg >> 2, g = bg & 3, cc = c > 254 ? 254 : c;
        return (unsigned)(((b * SEQ + 16 * cc) * 1024 + j * 256 + g * 64) * 2);
    }
    __device__ __forceinline__ const char* bptr(const GUnit& u) const { return (const char*)Bt + (size_t)(u.pm >> 5) * 256 * 2048 * 2; }
    __device__ __forceinline__ void epi(const Acc& acc, const GUnit& u, int wr, int wc, int fr, int fq) const {
        const int j = u.pm >> 5;
        EPI_FOR_ROWS(ai, m) { const int row = u.pm * 256 + ai * 128 + wr * 64 + m * 16 + fr; const int col = wc * 32 + fq * 8;
            const f32x4 b0 = *(const f32x4*)(b1p + j * 128 + col), b1 = *(const f32x4*)(b1p + j * 128 + col + 4);
            const f32x4 v0 = acc[ai][0][m][0] + b0, v1 = acc[ai][0][m][1] + b1;
            v4u w; w.x = cvt_pk_bf16(gelu_tanh_(v0[0]), gelu_tanh_(v0[1])); w.y = cvt_pk_bf16(gelu_tanh_(v0[2]), gelu_tanh_(v0[3]));
            w.z = cvt_pk_bf16(gelu_tanh_(v1[0]), gelu_tanh_(v1[1])); w.w = cvt_pk_bf16(gelu_tanh_(v1[2]), gelu_tanh_(v1[3]));
            *(v4u*)(HMID + (size_t)row * 128 + col) = w; }
    }
};
struct GroupedBase {
    const bf16* A; const bf16* Wb; int nt; size_t kstepA, kstepB; unsigned pitchA, pitchB; int nu; size_t wstride_e, wstride_pn;
    const LAS int* desc; const LAS int* rows;
    __device__ __forceinline__ bool next(int i, GUnit& u) const { if (i >= nu) return false; u.pm = i; u.e = desc[i * 4 + 0]; u.pn = desc[i * 4 + 1]; u.cnt = desc[i * 4 + 2]; return true; }
    __device__ __forceinline__ const char* bptr(const GUnit& u) const { return (const char*)Wb + (size_t)u.e * wstride_e + (size_t)u.pn * wstride_pn; }
};
struct PolSwigluGrouped : GroupedBase {
    bf16* H; const LAS float* wrow;
    __device__ __forceinline__ unsigned arow(const GUnit& u, int row) const { const int a = rows[u.pm * 256 + row]; return a < 0 ? 0u : (unsigned)(a >> 3) * pitchA; }
    __device__ __forceinline__ void epi(const Acc& acc, const GUnit& u, int wr, int wc, int fr, int fq) const {
        EPI_FOR_ROWS(ai, m) { const int row = ai * 128 + wr * 64 + m * 16 + fr; const int a = rows[u.pm * 256 + row]; const int col = u.pn * 128 + wc * 32 + fq * 8;
            if (a >= 0) { const float rw = wrow[u.pm * 256 + row];
            const f32x4 g0 = acc[ai][0][m][0], g1 = acc[ai][0][m][1], u0 = acc[ai][1][m][0] * rw, u1 = acc[ai][1][m][1] * rw;
            v4u w; w.x = cvt_pk_bf16(silu_(g0[0]) * u0[0], silu_(g0[1]) * u0[1]); w.y = cvt_pk_bf16(silu_(g0[2]) * u0[2], silu_(g0[3]) * u0[3]);
            w.z = cvt_pk_bf16(silu_(g1[0]) * u1[0], silu_(g1[1]) * u1[1]); w.w = cvt_pk_bf16(silu_(g1[2]) * u1[2], silu_(g1[3]) * u1[3]);
            *(v4u*)(H + (size_t)a * 256 + col) = w; } }
    }
};
struct PolDownGrouped : GroupedBase {
    bf16* Y;
    __device__ __forceinline__ unsigned arow(const GUnit& u, int row) const { const int a = rows[u.pm * 256 + row]; return a < 0 ? 0u : (unsigned)a * pitchA; }
    __device__ __forceinline__ void epi(const Acc& acc, const GUnit& u, int wr, int wc, int fr, int fq) const {
        EPI_FOR_ROWS(ai, m) { const int row = ai * 128 + wr * 64 + m * 16 + fr; const int a = rows[u.pm * 256 + row];
            if (a >= 0) {
#pragma unroll
            for (int bj = 0; bj < 2; ++bj) { const int col = u.pn * 256 + bj * 128 + wc * 32 + fq * 8; const f32x4 v0 = acc[ai][bj][m][0], v1 = acc[ai][bj][m][1];
                v4u w; w.x = cvt_pk_bf16(v0[0], v0[1]); w.y = cvt_pk_bf16(v0[2], v0[3]); w.z = cvt_pk_bf16(v1[0], v1[1]); w.w = cvt_pk_bf16(v1[2], v1[3]);
                *(v4u*)(Y + (size_t)a * D + col) = w; } } }
    }
};

__device__ __forceinline__ float wave_sum(float v) {
#pragma unroll
    for (int o = 1; o < 64; o <<= 1) v += __shfl_xor(v, o);
    return v;
}
__device__ __forceinline__ void tr_item(const float* W, int ldw, int k0, int n0, bf16* WT, int dstK, int drow0, float scale, LAS float* scr, int lane) {
#pragma unroll 8
    for (int i = 0; i < 32; ++i) { const int kk = 2 * i + (lane >> 5); scr[kk * 33 + (lane & 31)] = W[(size_t)(k0 + kk) * ldw + n0 + (lane & 31)] * scale; }
    LDS_WAIT(); asm volatile("" ::: "memory");
    const int c = lane & 7;
#pragma unroll
    for (int j = 0; j < 4; ++j) { const int n = (lane >> 3) + 8 * j; const LAS float* s = scr + (8 * c) * 33 + n;
        v4u o; o.x = pk2(s[0 * 33], s[1 * 33]); o.y = pk2(s[2 * 33], s[3 * 33]); o.z = pk2(s[4 * 33], s[5 * 33]); o.w = pk2(s[6 * 33], s[7 * 33]);
        *(v4u*)(WT + (size_t)(drow0 + n) * dstK + k0 + 8 * c) = o; }
    LDS_WAIT(); asm volatile("" ::: "memory");
}
struct TJob { const float* src; int K, ldw, col0, ncols; bf16* dst; int dstK, drow0; float scale; };
__device__ __forceinline__ void tr_job_item(const TJob& j, int item, LAS float* scr, int lane) {
    const int nblk = j.ncols / 32, kb = item / nblk, nb = item % nblk;
    tr_item(j.src, j.ldw, 64 * kb, j.col0 + 32 * nb, j.dst, j.dstK, j.drow0 + 32 * nb, j.scale, scr, lane);
}
constexpr int N_SMALL_JOBS = 36;
__device__ __forceinline__ TJob small_job(const Frame& F, int j) {
    unsigned char* ws = F.ws; const float* const (&in)[26] = F.in;
    TJob t; t.scale = 1.f; t.col0 = 0; t.drow0 = 0;
    if (j < 3) {
        t.src = in[2]; t.K = 1024; t.ldw = 3088; t.col0 = 1024 * j; t.ncols = 1024; t.dstK = 1024;
        if (j == 0) { t.dst = (bf16*)(ws + WS_W_FQK); t.scale = QSCALE; } else if (j == 1) { t.dst = (bf16*)(ws + WS_W_FQK); t.drow0 = 1024; } else t.dst = (bf16*)(ws + WS_W_FV);
    } else if (j == 3) { t.src = in[4]; t.K = 1024; t.ldw = 1024; t.ncols = 1024; t.dst = (bf16*)(ws + WS_W_FO); t.dstK = 1024;
    } else if (j < 10) {
        const int s = j - 4; t.src = in[5]; t.K = 1024; t.ldw = 1536; t.col0 = 256 * s; t.ncols = 256; t.dstK = 1024;
        if (s == 3) { t.dst = (bf16*)(ws + WS_W_KVTR); t.drow0 = 0; } else if (s == 5) { t.dst = (bf16*)(ws + WS_W_KVTR); t.drow0 = 256; } else { t.dst = (bf16*)(ws + WS_W_KVTOK); t.drow0 = (s == 0) ? 0 : (s == 1) ? 256 : (s == 2) ? 512 : 768; }
    } else if (j == 10) { t.src = in[10]; t.K = 1024; t.ldw = 1072; t.ncols = 1024; t.dst = (bf16*)(ws + WS_W_NQ); t.dstK = 1024; t.scale = QSCALE;
    } else if (j == 11) { t.src = in[12]; t.K = 1024; t.ldw = 1024; t.ncols = 1024; t.dst = (bf16*)(ws + WS_W_NO); t.dstK = 1024;
    } else if (j < 14) { const int L = j - 12; t.src = in[15] + (size_t)L * 1024 * 256; t.K = 1024; t.ldw = 256; t.ncols = 256; t.dst = (bf16*)(ws + WS_W_RT) + (size_t)L * 256 * 1024; t.dstK = 1024;
    } else if (j < 22) {
        const int q = j - 14, L = q >> 2, which = (q >> 1) & 1, half = q & 1;
        t.src = (which ? in[21] : in[20]) + (size_t)L * 1024 * 256; t.K = 1024; t.ldw = 256; t.col0 = 128 * half; t.ncols = 128; t.dst = (bf16*)(ws + WS_W_SGU) + (size_t)L * 512 * 1024; t.dstK = 1024; t.drow0 = half * 256 + which * 128;
    } else if (j < 24) { const int L = j - 22; t.src = in[22] + (size_t)L * 256 * 1024; t.K = 256; t.ldw = 1024; t.ncols = 1024; t.dst = (bf16*)(ws + WS_W_SD) + (size_t)L * 1024 * 256; t.dstK = 256;
    } else if (j < 26) { const int L = j - 24; t.src = in[23] + (size_t)L * 256 * 1024; t.K = 256; t.ldw = 1024; t.ncols = 1024; t.dst = (bf16*)(ws + WS_W_PP) + (size_t)L * 1024 * 256; t.dstK = 256;
    } else if (j < 28) { const int L = j - 26; t.src = in[24] + (size_t)L * 1024 * 1024; t.K = 1024; t.ldw = 1024; t.ncols = 1024; t.dst = (bf16*)(ws + WS_W_PG) + (size_t)L * 1024 * 1024; t.dstK = 1024;
    } else if (j < 30) { const int jj = j - 28; t.src = in[7] + (size_t)jj * 2048 * 128; t.K = 2048; t.ldw = 128; t.ncols = 128; t.dst = (bf16*)(ws + WS_W_C1) + (size_t)jj * 256 * 2048; t.dstK = 2048;
    } else { t.src = nullptr; t.K = 0; t.ldw = 0; t.ncols = 32; t.dst = nullptr; t.dstK = 0; }
    return t;
}
__device__ __forceinline__ void p_prologue(Frame& F) {
    LAS float* scr = (LAS float*)(F.lds + RING_OFF + F.wave * 16384);
    const int gw = F.bid * NWAVES + F.wave, NGW = F.G * NWAVES;
    unsigned char* ws = F.ws;
    for (int j = 0; j < 30; ++j) {
        const TJob t = small_job(F, j);
        const int items = (t.K / 64) * (t.ncols / 32);
        for (int it = gw; it < items; it += NGW) tr_job_item(t, it, scr, F.lane);
    }
    {
        const long total = 512L * 384;
        for (long it = gw; it < total; it += NGW) {
            const int le = (int)(it / 384), r = (int)(it % 384), which = r >> 7, idx = r & 127;
            if (which < 2) {
                const float* src = (which ? F.in[18] : F.in[17]) + (size_t)le * 1024 * 256;
                const int kb = idx >> 3, nb = idx & 7, n0 = 32 * nb;
                bf16* dst = (bf16*)(ws + WS_W_EGU) + (size_t)le * 512 * 1024;
                tr_item(src, 256, 64 * kb, n0, dst, 1024, (n0 >> 7) * 256 + which * 128 + (n0 & 127), 1.f, scr, F.lane);
            } else {
                const float* src = F.in[19] + (size_t)le * 256 * 1024;
                const int kb = idx >> 5, nb = idx & 31;
                bf16* dst = (bf16*)(ws + WS_W_ED) + (size_t)le * 1024 * 256;
                tr_item(src, 1024, 64 * kb, 32 * nb, dst, 256, 32 * nb, 1.f, scr, F.lane);
            }
        }
    }
    {
        const size_t gt = (size_t)F.bid * NTHREADS + F.tid, NT = (size_t)F.G * NTHREADS;
        const float* x = F.in[0]; bf16* xb = (bf16*)(ws + WS_XB);
        for (size_t i = gt; i < (size_t)NTOK * D / 8; i += NT) { const f32x4 a = *(const f32x4*)(x + i * 8), b = *(const f32x4*)(x + i * 8 + 4);
            v4u w; w.x = pk2(a[0], a[1]); w.y = pk2(a[2], a[3]); w.z = pk2(b[0], b[1]); w.w = pk2(b[2], b[3]); *(v4u*)(xb + i * 8) = w; }
        const float* pp = F.in[1]; bf16* pb = (bf16*)(ws + WS_PB);
        for (size_t i = gt; i < (size_t)2 * NTOK * PLE / 8; i += NT) { const f32x4 a = *(const f32x4*)(pp + i * 8), b = *(const f32x4*)(pp + i * 8 + 4);
            v4u w; w.x = pk2(a[0], a[1]); w.y = pk2(a[2], a[3]); w.z = pk2(b[0], b[1]); w.w = pk2(b[2], b[3]); *(v4u*)(pb + i * 8) = w; }
        bf16* wc1 = (bf16*)(ws + WS_W_C1);
        for (size_t i = gt; i < (size_t)2 * 128 * 2048 / 8; i += NT) { const size_t jj = i / (128 * 2048 / 8), r = i % (128 * 2048 / 8); *(v4u*)(wc1 + jj * 256 * 2048 + 128 * 2048 + r * 8) = (v4u){0u, 0u, 0u, 0u}; }
    }
    {
        const int gt = F.bid * NTHREADS + F.tid, NT = F.G * NTHREADS;
        bf16* fg = (bf16*)(ws + WS_W_FG); bf16* ng = (bf16*)(ws + WS_W_NG);
        for (int i = gt; i < 16 * D; i += NT) { const int c = i >> 10, k = i & 1023; fg[i] = (bf16)f2bf(F.in[2][(size_t)k * 3088 + 3072 + c]); }
        for (int i = gt; i < 48 * D; i += NT) { const int c = i >> 10, k = i & 1023; ng[i] = (bf16)f2bf(F.in[10][(size_t)k * 1072 + 1024 + c]); }
    }
    if (F.bid == 0 && F.tid < 256) {
        const int j = F.tid >> 7, col = F.tid & 127; const float* pe = F.in[6] + j * 2048; const float* w1 = F.in[7] + (size_t)j * 2048 * 128 + col;
        float s = F.in[8][j * 128 + col];
        for (int k = 0; k < 2048; ++k) s += pe[k] * w1[(size_t)k * 128];
        ((float*)(ws + WS_B1P))[j * 128 + col] = s;
    }
}

template <int NCT, int ACT>
__device__ __forceinline__ void p_gateproj(Frame& F, const bf16* XBp, const bf16* Wt, const float* bias, float* OUT) {
    const int gw = F.bid * NWAVES + F.wave, NGW = F.G * NWAVES, lane = F.lane, lr = lane & 15, lq = lane >> 4;
    constexpr int NC = 16 * NCT;
    for (int g = gw; g < NTOK / 16; g += NGW) {
        const bf16* ap = XBp + (size_t)(g * 16 + lr) * D + lq * 8; const bf16* bp = Wt + (size_t)lr * D + lq * 8;
        f32x4 acc[NCT];
#pragma unroll
        for (int c = 0; c < NCT; ++c) acc[c] = (f32x4){0.f, 0.f, 0.f, 0.f};
#pragma unroll 8
        for (int ks = 0; ks < D / 32; ++ks) {
            const bf16x8 a = *(const bf16x8*)(ap + ks * 32);
#pragma unroll
            for (int c = 0; c < NCT; ++c) { const bf16x8 b = *(const bf16x8*)(bp + (size_t)c * 16 * D + ks * 32); acc[c] = __builtin_amdgcn_mfma_f32_16x16x32_bf16(a, b, acc[c], 0, 0, 0); }
        }
#pragma unroll
        for (int c = 0; c < NCT; ++c) { const float bb = bias[c * 16 + lr];
#pragma unroll
            for (int r = 0; r < 4; ++r) { const float z = acc[c][r] + bb; float o;
                if (ACT == 0) o = fminf(z, 0.f) - log1pf(__expf(-fabsf(z))); else o = sigmoidf_(z);
                OUT[(size_t)(g * 16 + lq * 4 + r) * NC + c * 16 + lr] = o; } }
    }
}
__device__ __forceinline__ void p_scan(Frame& F) {
    if (F.bid >= NB) return;
    const float* lf = (const float*)(F.ws + WS_LOGF) + (size_t)F.bid * SEQ * 16; float* c2 = (float*)(F.ws + WS_C2) + (size_t)F.bid * SEQ * 16;
    LAS float* sums = (LAS float*)(F.lds + RING_OFF);
    const int h = F.tid & 15, ch = F.tid >> 4;
    float s = 0.f;
    for (int i = 0; i < 128; ++i) s += lf[(size_t)(ch * 128 + i) * 16 + h];
    sums[ch * 16 + h] = s;
    __syncthreads();
    float run = 0.f;
    for (int q = 0; q < ch; ++q) run += sums[q * 16 + h];
    for (int i = 0; i < 128; ++i) { run += lf[(size_t)(ch * 128 + i) * 16 + h]; c2[(size_t)(ch * 128 + i) * 16 + h] = run * LOG2E; }
    __syncthreads();
}

template <int MODE, bool WRITE_XB>
__device__ __forceinline__ void p_ln(Frame& F, float* PRE, const bf16* Y, const float* g, const float* b, bf16* XB) {
    const int gw = F.bid * NWAVES + F.wave, NGW = F.G * NWAVES;
    f32x4 gv[4], bv[4];
#pragma unroll
    for (int j = 0; j < 4; ++j) { gv[j] = *(const f32x4*)(g + 4 * F.lane + 256 * j); bv[j] = *(const f32x4*)(b + 4 * F.lane + 256 * j); }
    for (int row = gw; row < NTOK; row += NGW) {
        float* pr = PRE + (size_t)row * D + 4 * F.lane;
        f32x4 v[4]; float s = 0.f;
#pragma unroll
        for (int j = 0; j < 4; ++j) v[j] = *(const f32x4*)(pr + 256 * j);
        if (MODE == 1) {
#pragma unroll
            for (int k = 0; k < 8; ++k) { const bf16* yr = Y + ((size_t)row * 8 + k) * D + 4 * F.lane;
#pragma unroll
                for (int j = 0; j < 4; ++j) { const v2u w = *(const v2u*)(yr + 256 * j); v[j][0] += bf_lo(w.x); v[j][1] += bf_hi(w.x); v[j][2] += bf_lo(w.y); v[j][3] += bf_hi(w.y); } }
        }
#pragma unroll
        for (int j = 0; j < 4; ++j) s += (v[j][0] + v[j][1]) + (v[j][2] + v[j][3]);
        const float mean = wave_sum(s) * (1.f / D); float s2 = 0.f;
#pragma unroll
        for (int j = 0; j < 4; ++j) { v[j] = v[j] - mean; s2 += (v[j][0] * v[j][0] + v[j][1] * v[j][1]) + (v[j][2] * v[j][2] + v[j][3] * v[j][3]); }
        const float rstd = 1.f / sqrtf(wave_sum(s2) * (1.f / D) + LN_EPS);
#pragma unroll
        for (int j = 0; j < 4; ++j) { const f32x4 o = v[j] * rstd * gv[j] + bv[j]; *(f32x4*)(pr + 256 * j) = o;
            if (WRITE_XB) { v2u w; w.x = pk2(o[0], o[1]); w.y = pk2(o[2], o[3]); *(v2u*)(XB + (size_t)row * D + 4 * F.lane + 256 * j) = w; } }
    }
}

__device__ __forceinline__ void p_route(Frame& F, int L) {
    const int gw = F.bid * NWAVES + F.wave, NGW = F.G * NWAVES, lane = F.lane;
    const float* SC = (const float*)(F.ws + WS_SCORES); const float* br = F.in[16] + L * NE;
    unsigned* cnt = F.ctl + CW_CNT + L * NE; int* lists = (int*)(F.ws + WS_LISTS); float* wts = (float*)(F.ws + WS_WTS);
    const f32x4 bq = *(const f32x4*)(br + 4 * lane);
    for (int t = gw; t < NTOK; t += NGW) {
        const f32x4 lg = *(const f32x4*)(SC + (size_t)t * NE + 4 * lane);
        float sc[4], bs[4];
#pragma unroll
        for (int i = 0; i < 4; ++i) { sc[i] = sigmoidf_(lg[i]); bs[i] = sc[i] + bq[i]; }
        float m1 = fmaxf(bs[0], bs[1]), m2 = fminf(bs[0], bs[1]);
        { const float a = bs[2]; const float n1 = fmaxf(m1, a); m2 = fmaxf(fminf(m1, a), m2); m1 = n1; }
        { const float a = bs[3]; const float n1 = fmaxf(m1, a); m2 = fmaxf(fminf(m1, a), m2); m1 = n1; }
#pragma unroll
        for (int o = 1; o < 8; o <<= 1) { const float o1 = __shfl_xor(m1, o), o2 = __shfl_xor(m2, o); const float n1 = fmaxf(m1, o1); m2 = fmaxf(fminf(m1, o1), fmaxf(m2, o2)); m1 = n1; }
        const float gs = m1 + m2; const int mygrp = lane >> 3;
        int rank = 0;
#pragma unroll
        for (int gg = 0; gg < 8; ++gg) { const float og = __shfl(gs, gg * 8); rank += (og > gs || (og == gs && gg < mygrp)) ? 1 : 0; }
        const bool gsel = rank < 4;
        float cand[4];
#pragma unroll
        for (int i = 0; i < 4; ++i) cand[i] = gsel ? bs[i] : NEGBIG;
        float ssel = 0.f; int esel = 0; float ssum = 0.f;
#pragma unroll 1
        for (int k = 0; k < TOPK; ++k) {
            float bv = cand[0]; int bi = 4 * lane;
#pragma unroll
            for (int i = 1; i < 4; ++i) if (cand[i] > bv) { bv = cand[i]; bi = 4 * lane + i; }
#pragma unroll
            for (int o = 1; o < 64; o <<= 1) { const float ov = __shfl_xor(bv, o); const int oi = __shfl_xor(bi, o); if (ov > bv || (ov == bv && oi < bi)) { bv = ov; bi = oi; } }
            const int own = bi >> 2, sub = bi & 3;
            float sv = sub == 0 ? sc[0] : sub == 1 ? sc[1] : sub == 2 ? sc[2] : sc[3];
            sv = __shfl(sv, own);
            if (lane == own) { if (sub == 0) cand[0] = -3e38f; else if (sub == 1) cand[1] = -3e38f; else if (sub == 2) cand[2] = -3e38f; else cand[3] = -3e38f; }
            ssum += sv;
            if (lane == k) { ssel = sv; esel = bi; }
        }
        if (lane < TOPK) {
            const float w = ssel / ssum * 2.5f;
            const unsigned pos = atomicAdd(&cnt[esel], 1u);
            lists[(size_t)esel * NTOK + pos] = t * 8 + lane;
            wts[t * 8 + lane] = w;
        }
    }
}
__device__ __forceinline__ int build_units(Frame& F, int L, int nN) {
    LAS int* cum = (LAS int*)(F.lds + TBL_OFF); LAS int* cn = cum + 260; LAS int* desc = (LAS int*)(F.lds + DESC_OFF); LAS int* rows = (LAS int*)(F.lds + ROWS_OFF);
    const int* lists = (const int*)(F.ws + WS_LISTS);
    __syncthreads();
    if (F.tid < NE) { const int c = (int)__hip_atomic_load(F.ctl + CW_CNT + L * NE + F.tid, RLX_AGENT); cn[F.tid] = c; }
    __syncthreads();
    if (F.tid <= NE) { int s = 0; for (int i = 0; i < F.tid; ++i) s += (cn[i] + 255) >> 8; cum[F.tid] = s; }
    __syncthreads();
    const int total = cum[NE] * nN;
    int nu = 0;
    for (int i = 0; i < (nN == 2 ? 13 : MAXU); ++i) {
        const int Lu = i * F.G + F.bid; if (Lu >= total) break;
        const int mt = Lu / nN, pn = Lu % nN;
        int lo = 0, hi = NE;
        while (hi - lo > 1) { const int mid = (lo + hi) >> 1; if (cum[mid] <= mt) lo = mid; else hi = mid; }
        const int e = lo, r0 = (mt - cum[e]) * 256; int cnt = cn[e] - r0; cnt = cnt > 256 ? 256 : cnt;
        if (F.tid == 0) { desc[i * 4 + 0] = e; desc[i * 4 + 1] = pn; desc[i * 4 + 2] = cnt; desc[i * 4 + 3] = r0; }
        if (F.tid < 256) { const int a = F.tid < cnt ? lists[(size_t)e * NTOK + r0 + F.tid] : -1; rows[i * 256 + F.tid] = a;
            if (nN == 2 && i < 13) ((LAS float*)(F.lds + ROWS_OFF + 13 * 1024))[i * 256 + F.tid] = a >= 0 ? ((const float*)(F.ws + WS_WTS))[a] : 0.f; }
        nu = i + 1;
    }
    __syncthreads();
    return nu;
}

__device__ __forceinline__ void p_cmp2(Frame& F) {
    LAS float* w2 = (LAS float*)(F.lds + RING_OFF);
    for (int i = F.tid; i < 2 * 128 * 64; i += NTHREADS) w2[i] = F.in[9][i];
    __syncthreads();
    const bf16* hm = (const bf16*)(F.ws + WS_HMID); bf16* kc = (bf16*)(F.ws + WS_KC); bf16* vct = (bf16*)(F.ws + WS_VCT);
    const int total = 2 * 8192 * 16;
    for (int it = F.bid * NTHREADS + F.tid; it < total; it += F.G * NTHREADS) {
        const int d4 = it & 15, r = (it >> 4) & 8191, j = it >> 17, c = r & 255, bg = r >> 8;
        float a0 = 0.f, a1 = 0.f, a2 = 0.f, a3 = 0.f;
        if (c < 255) {
            const bf16* hr = hm + ((size_t)j * 8192 + r) * 128; const LAS float* w = w2 + j * 8192 + d4 * 4;
            for (int k = 0; k < 128; k += 2) { const unsigned hh = *(const unsigned*)(hr + k); const float h0 = bf_lo(hh), h1 = bf_hi(hh);
                const f32x4 wa = *(const LAS f32x4*)(w + k * 64), wb = *(const LAS f32x4*)(w + (k + 1) * 64);
                a0 += h0 * wa[0] + h1 * wb[0]; a1 += h0 * wa[1] + h1 * wb[1]; a2 += h0 * wa[2] + h1 * wb[2]; a3 += h0 * wa[3] + h1 * wb[3]; }
        }
        if (j == 0) { v2u w; w.x = pk2(a0, a1); w.y = pk2(a2, a3); *(v2u*)(kc + ((size_t)bg * 256 + c) * 64 + d4 * 4) = w; }
        else { bf16* o = vct + ((size_t)bg * 64 + d4 * 4) * 256 + c; o[0] = (bf16)f2bf(a0); o[256] = (bf16)f2bf(a1); o[512] = (bf16)f2bf(a2); o[768] = (bf16)f2bf(a3); }
    }
    __syncthreads();
}

constexpr int KP = 144, VP = 136;
constexpr int AT_BUF = 64 * KP + 64 * VP;
constexpr int AT_CK = 2 * AT_BUF;
constexpr int AT_IMP = AT_CK + 512;
constexpr int AT_MASK = AT_IMP + 64 * 65 * 4;
constexpr int AT_UNI = AT_MASK + 512;
constexpr int AT_OACC = AT_UNI + 64;
constexpr int AT_END = AT_OACC + 32 * 512 * 4;
static_assert(AT_END <= RING_BYTES, "attention LDS");

struct TileRegs { v4u k, v; };
__device__ __forceinline__ void at_load(TileRegs& r, const bf16* kbase, size_t kpitch_e, const bf16* vbase, size_t vpitch_e, int tid) {
    const int row = tid >> 3, ch = tid & 7;
    r.k = *(const v4u*)(kbase + (size_t)row * kpitch_e + ch * 8);
    r.v = *(const v4u*)(vbase + (size_t)row * vpitch_e + ch * 8);
}
__device__ __forceinline__ void at_store(LAS unsigned char* buf, const TileRegs& r, int tid) {
    const int row = tid >> 3, ch = tid & 7;
    *(LAS v4u*)(buf + row * KP + ch * 16) = r.k;
    LAS unsigned char* vp = buf + 64 * KP + row * VP + ch * 16;
    *(LAS v2u*)(vp) = (v2u){r.v.x, r.v.y}; *(LAS v2u*)(vp + 8) = (v2u){r.v.z, r.v.w};
}
__device__ __forceinline__ void at_qk(const LAS unsigned char* buf, const bf16x8 (&Qf)[4], f32x16& S0, f32x16& S1, int lane) {
    const LAS unsigned char* kb = buf + (lane & 31) * KP + (lane >> 5) * 16;
#pragma unroll
    for (int ks = 0; ks < 4; ++ks) {
        const bf16x8 k0 = *(const LAS bf16x8*)(kb + ks * 32), k1 = *(const LAS bf16x8*)(kb + 32 * KP + ks * 32);
        S0 = __builtin_amdgcn_mfma_f32_32x32x16_bf16(k0, Qf[ks], S0, 0, 0, 0);
        S1 = __builtin_amdgcn_mfma_f32_32x32x16_bf16(k1, Qf[ks], S1, 0, 0, 0);
    }
}
__device__ __forceinline__ void at_pv(const LAS unsigned char* buf, const f32x16& P0, const f32x16& P1, f32x16& O0, f32x16& O1, int lane) {
    const LAS unsigned char* vb = buf + 64 * KP + (lane & 31) * VP + (lane >> 5) * 8;
#pragma unroll
    for (int s = 0; s < 4; ++s) {
        const f32x16& P = (s < 2) ? P0 : P1; const int rb = 8 * (s & 1);
        v4u pw; pw.x = cvt_pk_bf16(P[rb + 0], P[rb + 1]); pw.y = cvt_pk_bf16(P[rb + 2], P[rb + 3]); pw.z = cvt_pk_bf16(P[rb + 4], P[rb + 5]); pw.w = cvt_pk_bf16(P[rb + 6], P[rb + 7]);
        const bf16x8 pf = __builtin_bit_cast(bf16x8, pw);
        const v2u a0 = *(const LAS v2u*)(vb + 32 * s), a1 = *(const LAS v2u*)(vb + 32 * s + 16);
        const v2u b0 = *(const LAS v2u*)(vb + 32 * VP + 32 * s), b1 = *(const LAS v2u*)(vb + 32 * VP + 32 * s + 16);
        const bf16x8 v0 = __builtin_bit_cast(bf16x8, ((v4u){a0.x, a0.y, a1.x, a1.y})), v1 = __builtin_bit_cast(bf16x8, ((v4u){b0.x, b0.y, b1.x, b1.y}));
        O0 = __builtin_amdgcn_mfma_f32_32x32x16_bf16(v0, pf, O0, 0, 0, 0);
        O1 = __builtin_amdgcn_mfma_f32_32x32x16_bf16(v1, pf, O1, 0, 0, 0);
    }
}
#define KEY_OF(sub, reg, h) (32 * (sub) + ((reg) & 3) + 8 * ((reg) >> 2) + 4 * (h))

__device__ __forceinline__ void at_softmax(f32x16& S0, f32x16& S1, float& m, float& l, f32x16& O0, f32x16& O1) {
    float mx = S0[0];
#pragma unroll
    for (int r = 1; r < 16; ++r) mx = fmaxf(mx, S0[r]);
#pragma unroll
    for (int r = 0; r < 16; ++r) mx = fmaxf(mx, S1[r]);
    mx = xhalf_max(mx);
    const float mn = fmaxf(m, mx), mu = fmaxf(mn, -1e20f);
    const float alpha = fast_exp2(m - mn);
    float ps = 0.f;
#pragma unroll
    for (int r = 0; r < 16; ++r) { S0[r] = fast_exp2(S0[r] - mu); ps += S0[r]; }
#pragma unroll
    for (int r = 0; r < 16; ++r) { S1[r] = fast_exp2(S1[r] - mu); ps += S1[r]; }
    ps = xhalf_sum(ps);
    l = l * alpha + ps; m = mn;
    O0 = O0 * alpha; O1 = O1 * alpha;
}

__device__ __forceinline__ void p_qkmax(Frame& F) {
    const bf16* QK = (const bf16*)(F.ws + WS_QK);
    const int gw = F.bid * NWAVES + F.wave, NGW = F.G * NWAVES, lane = F.lane;
    const int b = gw & 7, wi = gw >> 3, nwb = (NGW + 7 - b) >> 3, hd = lane & 15;
    float qm = 0.f, km = 0.f;
    for (int grp = wi; grp < SEQ / 4; grp += nwb) {
        const size_t tok = (size_t)b * SEQ + grp * 4 + (lane >> 4);
        const bf16* qp = QK + tok * 2048 + hd * 64; const bf16* kp = qp + 1024;
        float qs = 0.f, ks = 0.f;
#pragma unroll
        for (int c = 0; c < 8; ++c) { const v4u qv = *(const v4u*)(qp + 8 * c), kv = *(const v4u*)(kp + 8 * c);
#pragma unroll
            for (int e = 0; e < 4; ++e) { const float q0 = bf_lo(qv[e]), q1 = bf_hi(qv[e]), k0 = bf_lo(kv[e]), k1 = bf_hi(kv[e]); qs += q0 * q0 + q1 * q1; ks += k0 * k0 + k1 * k1; } }
        qm = fmaxf(qm, qs); km = fmaxf(km, ks);
    }
    qm = fmaxf(qm, __shfl_xor(qm, 16)); qm = fmaxf(qm, __shfl_xor(qm, 32)); km = fmaxf(km, __shfl_xor(km, 16)); km = fmaxf(km, __shfl_xor(km, 32));
    if (lane < 16) { atomicMax(F.ctl + CW_KMAX + b * 16 + hd, __builtin_bit_cast(unsigned, km)); atomicMax(F.ctl + CW_KMAX + 128 + b * 16 + hd, __builtin_bit_cast(unsigned, qm)); }
}
__device__ __forceinline__ void p_fox_attn(Frame& F) {
    LAS unsigned char* lds = F.lds + RING_OFF;
    const bf16* QK = (const bf16*)(F.ws + WS_QK); const bf16* VT = (const bf16*)(F.ws + WS_VT); const float* C2 = (const float*)(F.ws + WS_C2); bf16* O = (bf16*)(F.ws + WS_O);
    const int tid = F.tid, lane = F.lane, w = F.wave, n = lane & 31, h = lane >> 5;
    for (int i = 0;; ++i) {
        const int idx = i * F.G + ((i & 1) ? (F.G - 1 - F.bid) : F.bid); if (idx >= NB * NH * 16) break;
        const int qb = 15 - idx / 128, bh = idx % 128, b = bh >> 4, hd = bh & 15;
        const int q0 = qb * 256, tq = q0 + 32 * w + n;
        const size_t tokq = (size_t)b * SEQ + tq;
        bf16x8 Qf[4];
#pragma unroll
        for (int ks = 0; ks < 4; ++ks) Qf[ks] = *(const bf16x8*)(QK + tokq * 2048 + hd * 64 + 16 * ks + 8 * h);
        const float kmax2 = __builtin_bit_cast(float, __hip_atomic_load(F.ctl + CW_KMAX + bh, RLX_AGENT)), qmax2 = __builtin_bit_cast(float, __hip_atomic_load(F.ctl + CW_KMAX + 128 + bh, RLX_AGENT));
        const float T = -140.f - 2.f * sqrtf(kmax2 * qmax2) * 1.01f;
        const float c2q0 = C2[((size_t)b * SEQ + q0) * 16 + hd], c2w0 = C2[((size_t)b * SEQ + q0 + 32 * w) * 16 + hd];
        f32x16 O0, O1;
#pragma unroll
        for (int r = 0; r < 16; ++r) { O0[r] = 0.f; O1[r] = 0.f; }
        float m = NEGBIG, l = 0.f;
        const int jmax = (q0 + 256) / 64 - 1;
        const bf16* kbase = QK + (size_t)b * SEQ * 2048 + 1024 + hd * 64;
        const bf16* vbase = VT + (size_t)(hd * 64) * NTOK + (size_t)b * SEQ;
        const float* cbase = C2 + (size_t)b * SEQ * 16 + hd;
        TileRegs tr; float ckr = 0.f;
        at_load(tr, kbase + (size_t)jmax * 64 * 2048, 2048, vbase + jmax * 64, NTOK, tid); if (tid < 64) ckr = cbase[(size_t)(jmax * 64 + tid) * 16];
        __syncthreads();
        at_store(lds, tr, tid); if (tid < 64) ((LAS float*)(lds + AT_CK))[tid] = ckr;
        __syncthreads();
#pragma unroll 1
        for (int jj = 0;; ++jj) {
            const int j = jmax - jj;
            LAS unsigned char* buf = lds + (jj & 1) * AT_BUF; LAS unsigned char* nbuf = lds + ((jj + 1) & 1) * AT_BUF;
            const LAS float* ck = (const LAS float*)(lds + AT_CK) + (jj & 1) * 64;
            const float ckf = __builtin_bit_cast(float, __builtin_amdgcn_readfirstlane(__builtin_bit_cast(unsigned, ck[0])));
            const float ckl = __builtin_bit_cast(float, __builtin_amdgcn_readfirstlane(__builtin_bit_cast(unsigned, ck[63])));
            const bool cont = (j > 0) && (c2q0 - ckf > T);
            if (cont) { at_load(tr, kbase + (size_t)(j - 1) * 64 * 2048, 2048, vbase + (j - 1) * 64, NTOK, tid); if (tid < 64) ckr = cbase[(size_t)((j - 1) * 64 + tid) * 16]; }
            if (64 * j <= q0 + 32 * w + 31 && (c2w0 - ckl > T)) {
                f32x16 S0, S1;
#pragma unroll
                for (int g = 0; g < 4; ++g) {
                    const f32x4 c0 = *(const LAS f32x4*)(ck + 8 * g + 4 * h), c1 = *(const LAS f32x4*)(ck + 32 + 8 * g + 4 * h);
#pragma unroll
                    for (int e = 0; e < 4; ++e) { S0[4 * g + e] = -c0[e]; S1[4 * g + e] = -c1[e]; }
                }
                at_qk(buf, Qf, S0, S1, lane);
                if (64 * j + 63 > q0 + 32 * w) {
                    const int rel = tq - 64 * j - 4 * h;
#pragma unroll
                    for (int r = 0; r < 16; ++r) { const int kk = (r & 3) + 8 * (r >> 2);
                        S0[r] = (kk <= rel) ? S0[r] : NEGBIG; S1[r] = (kk + 32 <= rel) ? S1[r] : NEGBIG; }
                }
                at_softmax(S0, S1, m, l, O0, O1);
                at_pv(buf, S0, S1, O0, O1, lane);
            }
            if (cont) { at_store(nbuf, tr, tid); if (tid < 64) ((LAS float*)(lds + AT_CK))[((jj + 1) & 1) * 64 + tid] = ckr; }
            __syncthreads();
            if (!cont) break;
        }
        const float inv = l > 0.f ? 1.f / l : 0.f;
        bf16* orow = O + tokq * D + hd * 64 + 4 * h;
#pragma unroll
        for (int g = 0; g < 4; ++g) {
            v2u w0; w0.x = cvt_pk_bf16(O0[4 * g] * inv, O0[4 * g + 1] * inv); w0.y = cvt_pk_bf16(O0[4 * g + 2] * inv, O0[4 * g + 3] * inv); *(v2u*)(orow + 8 * g) = w0;
            v2u w1; w1.x = cvt_pk_bf16(O1[4 * g] * inv, O1[4 * g + 1] * inv); w1.y = cvt_pk_bf16(O1[4 * g + 2] * inv, O1[4 * g + 3] * inv); *(v2u*)(orow + 32 + 8 * g) = w1;
        }
    }
}

__device__ __forceinline__ void p_nsa_attn(Frame& F) {
    LAS unsigned char* lds = F.lds + RING_OFF;
    const bf16* KVTOK = (const bf16*)(F.ws + WS_QK); const bf16* NQ = (const bf16*)(F.ws + WS_QK + 64 * MiB); const bf16* KVTR = (const bf16*)(F.ws + WS_VT);
    const bf16* KC = (const bf16*)(F.ws + WS_KC); const bf16* VCT = (const bf16*)(F.ws + WS_VCT); const float* GATES = (const float*)(F.ws + WS_GATES); bf16* O = (bf16*)(F.ws + WS_O);
    LAS float* IMP = (LAS float*)(lds + AT_IMP); LAS float* OACC = (LAS float*)(lds + AT_OACC) + F.tid; asm volatile("" : "+v"(OACC));     LAS u64* MASK = (LAS u64*)(lds + AT_MASK); LAS u64* UNI = (LAS u64*)(lds + AT_UNI);
    const int tid = F.tid, lane = F.lane, w = F.wave, n = lane & 31, h = lane >> 5, qq = n >> 2, rr = n & 3;
    for (int i = 0;; ++i) {
        const int idx = i * F.G + ((i & 1) ? (F.G - 1 - F.bid) : F.bid); if (idx >= NB * 4 * 64) break;
        const int tb = 63 - idx / 32, bg = idx % 32, b = bg >> 2, g = bg & 3;
        const int t0 = tb * 64, tq = t0 + 8 * w + qq, hd = 4 * g + rr;
        const size_t tokq = (size_t)b * SEQ + tq;
        const float slope2 = exp2f(-0.5f * (float)(hd + 1)) * LOG2E;
        bf16x8 Qf[4];
#pragma unroll
        for (int ks = 0; ks < 4; ++ks) Qf[ks] = *(const bf16x8*)(NQ + tokq * 1024 + hd * 64 + 16 * ks + 8 * h);
        const float gc = GATES[tokq * 48 + hd * 3 + 0], gsel = GATES[tokq * 48 + hd * 3 + 1], gw = GATES[tokq * 48 + hd * 3 + 2];
        for (int e = lane; e < 8 * 65; e += 64) IMP[(8 * w) * 65 + e] = 0.f;
        f32x16 OF0, OF1;
        TileRegs tr;
        const int ntc = ((t0 + 32) / 16) / 64 + 1;
        const bf16* kcb = KC + (size_t)bg * 256 * 64; const bf16* vcb = VCT + (size_t)bg * 64 * 256;
        float m = NEGBIG, l = 0.f;
#pragma unroll 1
        for (int pass = 0; pass < 2; ++pass) {
            f32x16 O0, O1;
#pragma unroll
            for (int r = 0; r < 16; ++r) { O0[r] = 0.f; O1[r] = 0.f; }
            const float mu = fmaxf(m, -1e20f), invl = l > 0.f ? 1.f / l : 0.f;
            float prev_o3 = 0.f;
            at_load(tr, kcb, 64, vcb, 256, tid);
            __syncthreads();
            at_store(lds, tr, tid);
            __syncthreads();
#pragma unroll 1
            for (int j = 0; j < ntc; ++j) {
                LAS unsigned char* buf = lds + (j & 1) * AT_BUF; LAS unsigned char* nbuf = lds + ((j + 1) & 1) * AT_BUF;
                if (j + 1 < ntc) at_load(tr, kcb + (size_t)(j + 1) * 64 * 64, 64, vcb + (j + 1) * 64, 256, tid);
                f32x16 S0, S1;
#pragma unroll
                for (int r = 0; r < 16; ++r) { S0[r] = 0.f; S1[r] = 0.f; }
                at_qk(buf, Qf, S0, S1, lane);
                const int cbase = tq - 31 - 1024 * j - 64 * h;
#pragma unroll
                for (int r = 0; r < 16; ++r) {
                    const int d0 = cbase - 16 * ((r & 3) + 8 * (r >> 2)), d1 = d0 - 512;
                    S0[r] = d0 >= 0 ? S0[r] - slope2 * (float)d0 : NEGBIG;
                    S1[r] = d1 >= 0 ? S1[r] - slope2 * (float)d1 : NEGBIG;
                }
                if (pass == 0) {
                    float mx = S0[0];
#pragma unroll
                    for (int r = 1; r < 16; ++r) mx = fmaxf(mx, S0[r]);
#pragma unroll
                    for (int r = 0; r < 16; ++r) mx = fmaxf(mx, S1[r]);
                    mx = xhalf_max(mx);
                    const float mn = fmaxf(m, mx), mu0 = fmaxf(mn, -1e20f);
                    float ps = 0.f;
#pragma unroll
                    for (int r = 0; r < 16; ++r) ps += fast_exp2(S0[r] - mu0) + fast_exp2(S1[r] - mu0);
                    ps = xhalf_sum(ps);
                    l = l * fast_exp2(m - mn) + ps; m = mn;
                } else {
#pragma unroll
                    for (int r = 0; r < 16; ++r) { S0[r] = fast_exp2(S0[r] - mu) * invl; S1[r] = fast_exp2(S1[r] - mu) * invl; }
                    at_pv(buf, S0, S1, O0, O1, lane);
#pragma unroll
                    for (int sub = 0; sub < 2; ++sub)
#pragma unroll
                        for (int u = 0; u < 4; ++u) {
                            float P[4];
#pragma unroll
                            for (int e = 0; e < 4; ++e) { float x = sub == 0 ? S0[4 * u + e] : S1[4 * u + e]; x += __shfl_xor(x, 1); x += __shfl_xor(x, 2); P[e] = x; }
                            const float loc = 2.f * (P[0] + P[1] + P[2]) + P[3];
                            const float o3 = xhalf_other(P[3], h);
                            const float cross = h ? o3 : prev_o3;
                            prev_o3 = o3;
                            if (rr == 0) IMP[(8 * w + qq) * 65 + 16 * j + 8 * sub + 2 * u + h] = loc + cross;
                        }
                }
                if (j + 1 < ntc) at_store(nbuf, tr, tid);
                __syncthreads();
            }
            if (pass == 1) {
#pragma unroll
                for (int r = 0; r < 16; ++r) { OACC[r * 512] = O0[r] * gc; OACC[(16 + r) * 512] = O1[r] * gc; }
            }
        }
        LDS_WAIT();
        u64 wun = 0;
#pragma unroll 1
        for (int q = 0; q < 8; ++q) {
            const int tok = 8 * w + q, t = t0 + tok, cur = t >> 6, jb = lane;
            const bool vis = 64 * jb <= t, forced = (jb == 0) || (jb == cur) || (jb == cur - 1);
            const float sc = forced ? 1e9f : (vis ? IMP[tok * 65 + jb] : NEGBIG);
            int rank = 0;
#pragma unroll 8
            for (int ii = 0; ii < 64; ++ii) { const float si = __shfl(sc, ii); rank += (si > sc || (si == sc && ii < jb)) ? 1 : 0; }
            const u64 mk = __ballot(vis && rank < 16);
            if (lane == 0) MASK[tok] = mk;
            wun |= mk;
        }
        if (lane == 0) UNI[w] = wun;
        __syncthreads();
        const u64 mymask = MASK[8 * w + qq];
        u64 umask = 0;
#pragma unroll
        for (int q = 0; q < 8; ++q) umask |= UNI[q];
        { const unsigned lo = __builtin_amdgcn_readfirstlane((unsigned)umask), hi = __builtin_amdgcn_readfirstlane((unsigned)(umask >> 32)); umask = ((u64)hi << 32) | lo; }
        { const unsigned lo = __builtin_amdgcn_readfirstlane((unsigned)wun), hi = __builtin_amdgcn_readfirstlane((unsigned)(wun >> 32)); wun = ((u64)hi << 32) | lo; }
        {
            f32x16 O0, O1;
#pragma unroll
            for (int r = 0; r < 16; ++r) { O0[r] = 0.f; O1[r] = 0.f; }
            m = NEGBIG; l = 0.f;
            const bf16* kb = KVTOK + (size_t)b * SEQ * 1024 + 512 + g * 64; const bf16* vb = KVTR + (size_t)(g * 64) * NTOK + (size_t)b * SEQ;
            u64 rem = umask; int jt = rem ? __builtin_ctzll(rem) : 0; if (rem) rem &= rem - 1;
            const int nts = __builtin_popcountll(umask);
            at_load(tr, kb + (size_t)jt * 64 * 1024, 1024, vb + jt * 64, NTOK, tid);
            __syncthreads();
            at_store(lds, tr, tid);
            __syncthreads();
#pragma unroll 1
            for (int j = 0; j < nts; ++j) {
                LAS unsigned char* buf = lds + (j & 1) * AT_BUF; LAS unsigned char* nbuf = lds + ((j + 1) & 1) * AT_BUF;
                int jn = 0; if (j + 1 < nts) { jn = __builtin_ctzll(rem); rem &= rem - 1; at_load(tr, kb + (size_t)jn * 64 * 1024, 1024, vb + jn * 64, NTOK, tid); }
                if ((wun >> jt) & 1ull) {
                    f32x16 S0, S1;
#pragma unroll
                    for (int r = 0; r < 16; ++r) { S0[r] = 0.f; S1[r] = 0.f; }
                    at_qk(buf, Qf, S0, S1, lane);
                    const bool selme = (mymask >> jt) & 1ull;
                    const int sbase = tq - 64 * jt - 4 * h;
#pragma unroll
                    for (int r = 0; r < 16; ++r) {
                        const int d0 = sbase - ((r & 3) + 8 * (r >> 2)), d1 = d0 - 32;
                        S0[r] = (selme && d0 >= 0) ? S0[r] - slope2 * (float)d0 : NEGBIG;
                        S1[r] = (selme && d1 >= 0) ? S1[r] - slope2 * (float)d1 : NEGBIG;
                    }
                    at_softmax(S0, S1, m, l, O0, O1);
                    at_pv(buf, S0, S1, O0, O1, lane);
                }
                if (j + 1 < nts) at_store(nbuf, tr, tid);
                jt = jn;
                __syncthreads();
            }
            const float sc = l > 0.f ? gsel / l : 0.f;
#pragma unroll
            for (int r = 0; r < 16; ++r) { OACC[r * 512] += O0[r] * sc; OACC[(16 + r) * 512] += O1[r] * sc; }
        }
        {
            f32x16 O0, O1;
#pragma unroll
            for (int r = 0; r < 16; ++r) { O0[r] = 0.f; O1[r] = 0.f; }
            m = NEGBIG; l = 0.f;
            const bf16* kb = KVTOK + (size_t)b * SEQ * 1024 + 768 + g * 64; const bf16* vb = KVTR + (size_t)(256 + g * 64) * NTOK + (size_t)b * SEQ;
            const int jlo = tb >= 8 ? tb - 8 : 0, ntw = tb - jlo + 1;
            at_load(tr, kb + (size_t)jlo * 64 * 1024, 1024, vb + jlo * 64, NTOK, tid);
            __syncthreads();
            at_store(lds, tr, tid);
            __syncthreads();
#pragma unroll 1
            for (int j = 0; j < ntw; ++j) {
                const int jt = jlo + j;
                LAS unsigned char* buf = lds + (j & 1) * AT_BUF; LAS unsigned char* nbuf = lds + ((j + 1) & 1) * AT_BUF;
                if (j + 1 < ntw) at_load(tr, kb + (size_t)(jt + 1) * 64 * 1024, 1024, vb + (jt + 1) * 64, NTOK, tid);
                f32x16 S0, S1;
#pragma unroll
                for (int r = 0; r < 16; ++r) { S0[r] = 0.f; S1[r] = 0.f; }
                at_qk(buf, Qf, S0, S1, lane);
                const int wbase = tq - 64 * jt - 4 * h;
#pragma unroll
                for (int r = 0; r < 16; ++r) {
                    const int d0 = wbase - ((r & 3) + 8 * (r >> 2)), d1 = d0 - 32;
                    S0[r] = (d0 >= 0 && d0 < 512) ? S0[r] - slope2 * (float)d0 : NEGBIG;
                    S1[r] = (d1 >= 0 && d1 < 512) ? S1[r] - slope2 * (float)d1 : NEGBIG;
                }
                at_softmax(S0, S1, m, l, O0, O1);
                at_pv(buf, S0, S1, O0, O1, lane);
                if (j + 1 < ntw) at_store(nbuf, tr, tid);
                __syncthreads();
            }
            const float sc = l > 0.f ? gw / l : 0.f;
#pragma unroll
            for (int r = 0; r < 16; ++r) { OF0[r] = OACC[r * 512] + O0[r] * sc; OF1[r] = OACC[(16 + r) * 512] + O1[r] * sc; }
        }
        bf16* orow = O + tokq * D + hd * 64 + 4 * h;
#pragma unroll
        for (int gq = 0; gq < 4; ++gq) {
            v2u w0; w0.x = cvt_pk_bf16(OF0[4 * gq], OF0[4 * gq + 1]); w0.y = cvt_pk_bf16(OF0[4 * gq + 2], OF0[4 * gq + 3]); *(v2u*)(orow + 8 * gq) = w0;
            v2u w1; w1.x = cvt_pk_bf16(OF1[4 * gq], OF1[4 * gq + 1]); w1.y = cvt_pk_bf16(OF1[4 * gq + 2], OF1[4 * gq + 3]); *(v2u*)(orow + 32 + 8 * gq) = w1;
        }
    }
}

constexpr int N_PHASES = 28;
__global__ void __launch_bounds__(NTHREADS, 2) fwd(Args args) {
    extern __shared__ __attribute__((aligned(16))) unsigned char lds_raw[];
    Frame F;
    F.lds = (LAS unsigned char*)lds_raw;
    F.MISC = (volatile LAS unsigned*)(F.lds + MISC_OFF);
    F.tid = threadIdx.x; F.lane = F.tid & 63; F.wave = __builtin_amdgcn_readfirstlane(F.tid >> 6);
    F.G = gridDim.x; F.bid = blockIdx.x;
    F.ws = args.ws; F.ctl = (unsigned*)(args.ws + WS_CTL); F.out = args.out;
#pragma unroll
    for (int i = 0; i < 26; ++i) F.in[i] = args.in[i];
    if (F.tid < 64) F.MISC[F.tid] = 0u;
    __syncthreads();
    XcdBarrier bar; bar.bar = F.ctl + CW_BAR; bar.x = 0; bar.st = nullptr;
    if (!MK_PER_PHASE) bar = xcd_barrier_post(F.ctl + CW_BAR, F.MISC + 8);
    const int lo = args.ph_lo, hi = args.ph_hi;
#define IN(k) (lo <= (k) && (k) < hi)
#define REPS(k) for (int _rep = 0; _rep < (((PROBE_REP) >> (k)) & 1ull ? 2 : 1); ++_rep)
#define SEAM(k) do { if (IN(k) && IN((k) + 1)) xcd_barrier(bar); } while (0)
    unsigned char* ws = F.ws;
    bf16* XB = (bf16*)(ws + WS_XB); float* XFA = (float*)(ws + WS_XFA); float* XFB = F.out;
    LAS unsigned char* ring = F.lds + RING_OFF;

    if (IN(0)) REPS(0) { p_prologue(F); }
    SEAM(0);
    if (IN(1)) REPS(1) {
        { PolBf16 P; P.setup(XB, (const bf16*)(ws + WS_W_FQK), NTOK, 2048, D, F.G, F.bid); P.O = (bf16*)(ws + WS_QK); P.ldc = 2048; g8::gemm_phase(ring, P); }
        { PolBf16 P; P.setup((const bf16*)(ws + WS_W_FV), XB, 1024, NTOK, D, F.G, F.bid); P.O = (bf16*)(ws + WS_VT); P.ldc = NTOK; g8::gemm_phase(ring, P); }
        { PolBf16 P; P.setup((const bf16*)(ws + WS_PB), (const bf16*)(ws + WS_W_PP), NTOK, D, PLE, F.G, F.bid); P.O = (bf16*)(ws + WS_PPROJ); P.ldc = D; g8::gemm_phase(ring, P); }
        p_gateproj<1, 0>(F, XB, (const bf16*)(ws + WS_W_FG), F.in[3], (float*)(ws + WS_LOGF));
    }
    SEAM(1);
    if (IN(2)) REPS(2) { p_scan(F); p_qkmax(F); }
    SEAM(2);
    if (IN(3)) REPS(3) { p_fox_attn(F); }
    SEAM(3);
    if (IN(4)) REPS(4) { PolResid P; P.setup((const bf16*)(ws + WS_O), (const bf16*)(ws + WS_W_FO), NTOK, D, D, F.G, F.bid); P.X = F.in[0]; P.PRE = XFA; g8::gemm_phase(ring, P); }
    SEAM(4);
    if (IN(5)) REPS(5) { p_ln<0, true>(F, XFA, nullptr, F.in[13] + 0 * D, F.in[14] + 0 * D, XB); }
    SEAM(5);
#define MOE_LAYER(L, PH, Xcur, Xoth, LASTLN)                                                                                                                          \
                                                                                                                           \
    if (IN(PH + 0)) REPS(PH + 0) {                                                                                                                                               \
        { PolF32 P; P.setup(XB, (const bf16*)(ws + WS_W_RT) + (size_t)(L) * 256 * 1024, NTOK, NE, D, F.G, F.bid); P.O = (float*)(ws + WS_SCORES); P.ldc = NE; g8::gemm_phase(ring, P); } \
        { PolSwigluPlain P; P.setup(XB, (const bf16*)(ws + WS_W_SGU) + (size_t)(L) * 512 * 1024, NTOK, 512, D, F.G, F.bid); P.H = (bf16*)(ws + WS_H); P.rowbase = (size_t)8 * NTOK; g8::gemm_phase(ring, P); } \
    }                                                                                                                                                               \
    SEAM(PH + 0);                                                                                                                                                   \
                                                                                                               \
    if (IN(PH + 1)) REPS(PH + 1) {                                                                                                                                               \
        p_route(F, L);                                                                                                                                              \
        { PolResid P; P.setup((const bf16*)(ws + WS_H) + (size_t)8 * NTOK * 256, (const bf16*)(ws + WS_W_SD) + (size_t)(L) * 1024 * 256, NTOK, D, EH, F.G, F.bid); P.X = Xcur; P.PRE = Xoth; g8::gemm_phase(ring, P); } \
    }                                                                                                                                                               \
    SEAM(PH + 1);                                                                                                                                                   \
                                                                                                                                           \
    if (IN(PH + 2)) REPS(PH + 2) {                                                                                                                                               \
        const int nu = build_units(F, L, 2);                                                                                                                        \
        PolSwigluGrouped P; P.A = XB; P.Wb = (const bf16*)(ws + WS_W_EGU) + (size_t)(L) * 256 * 512 * 1024; P.nt = D / 64; P.kstepA = 128; P.kstepB = 128; P.pitchA = D * 2; P.pitchB = D * 2; P.nu = nu; \
        P.wstride_e = (size_t)512 * 1024 * 2; P.wstride_pn = (size_t)256 * 1024 * 2; P.desc = (const LAS int*)(F.lds + DESC_OFF); P.rows = (const LAS int*)(F.lds + ROWS_OFF); P.wrow = (const LAS float*)(F.lds + ROWS_OFF + 13 * 1024); P.H = (bf16*)(ws + WS_H); \
        g8::gemm_phase(ring, P);                                                                                                                                    \
    }                                                                                                                                                               \
    SEAM(PH + 2);                                                                                                                                                   \
                                                                                                                                              \
    if (IN(PH + 3)) REPS(PH + 3) {                                                                                                                                               \
        const int nu = build_units(F, L, 4);                                                                                                                        \
        PolDownGrouped P; P.A = (const bf16*)(ws + WS_H); P.Wb = (const bf16*)(ws + WS_W_ED) + (size_t)(L) * 256 * 1024 * 256; P.nt = EH / 64; P.kstepA = 128; P.kstepB = 128; P.pitchA = EH * 2; P.pitchB = EH * 2; P.nu = nu; \
        P.wstride_e = (size_t)1024 * 256 * 2; P.wstride_pn = (size_t)256 * 256 * 2; P.desc = (const LAS int*)(F.lds + DESC_OFF); P.rows = (const LAS int*)(F.lds + ROWS_OFF); P.Y = (bf16*)(ws + WS_Y); \
        g8::gemm_phase(ring, P);                                                                                                                                    \
    }                                                                                                                                                               \
    SEAM(PH + 3);                                                                                                                                                   \
                                                                                                                                 \
    if (IN(PH + 4)) REPS(PH + 4) { p_ln<1, true>(F, Xoth, (const bf16*)(ws + WS_Y), F.in[13] + ((L) * 3 + 1) * D, F.in[14] + ((L) * 3 + 1) * D, XB); }                            \
    SEAM(PH + 4);                                                                                                                                                   \
                                                                                                              \
    if (IN(PH + 5)) REPS(PH + 5) { PolPle P; P.setup(XB, (const bf16*)(ws + WS_W_PG) + (size_t)(L) * 1024 * 1024, NTOK, D, D, F.G, F.bid); P.X = Xoth; P.PRE = Xcur; P.bias = F.in[25] + (L) * D; P.PP = (const bf16*)(ws + WS_PPROJ); g8::gemm_phase(ring, P); } \
    SEAM(PH + 5);                                                                                                                                                   \
                                                                                                                                           \
    if (IN(PH + 6)) REPS(PH + 6) { p_ln<0, !(LASTLN)>(F, Xcur, nullptr, F.in[13] + ((L) * 3 + 2) * D, F.in[14] + ((L) * 3 + 2) * D, XB); }

    MOE_LAYER(0, 6, XFA, XFB, false)
    SEAM(12);
    if (IN(13)) REPS(13) {
        { PolBf16 P; P.setup(XB, (const bf16*)(ws + WS_W_KVTOK), NTOK, 1024, D, F.G, F.bid); P.O = (bf16*)(ws + WS_QK); P.ldc = 1024; g8::gemm_phase(ring, P); }
        { PolBf16 P; P.setup(XB, (const bf16*)(ws + WS_W_NQ), NTOK, 1024, D, F.G, F.bid); P.O = (bf16*)(ws + WS_QK + 64 * MiB); P.ldc = 1024; g8::gemm_phase(ring, P); }
        { PolBf16 P; P.setup((const bf16*)(ws + WS_W_KVTR), XB, 512, NTOK, D, F.G, F.bid); P.O = (bf16*)(ws + WS_VT); P.ldc = NTOK; g8::gemm_phase(ring, P); }
        { PolBf16 P; P.setup((const bf16*)(ws + WS_PB) + (size_t)NTOK * PLE, (const bf16*)(ws + WS_W_PP) + (size_t)1024 * 256, NTOK, D, PLE, F.G, F.bid); P.O = (bf16*)(ws + WS_PPROJ); P.ldc = D; g8::gemm_phase(ring, P); }
        p_gateproj<3, 1>(F, XB, (const bf16*)(ws + WS_W_NG), F.in[11], (float*)(ws + WS_GATES));
    }
    SEAM(13);
    if (IN(14)) REPS(14) { PolCmp1 P; P.A = (const bf16*)(ws + WS_QK); P.Bt = (const bf16*)(ws + WS_W_C1); P.nt = 32; P.kstepA = 2048; P.kstepB = 128; P.pitchB = 4096; P.S.init(64, 1, F.G, F.bid); P.b1p = (const float*)(ws + WS_B1P); P.HMID = (bf16*)(ws + WS_HMID); g8::gemm_phase(ring, P); }
    SEAM(14);
    if (IN(15)) REPS(15) { p_cmp2(F); }
    SEAM(15);
    if (IN(16)) REPS(16) { p_nsa_attn(F); }
    SEAM(16);
    if (IN(17)) REPS(17) { PolResid P; P.setup((const bf16*)(ws + WS_O), (const bf16*)(ws + WS_W_NO), NTOK, D, D, F.G, F.bid); P.X = XFA; P.PRE = XFB; g8::gemm_phase(ring, P); }
    SEAM(17);
    if (IN(18)) REPS(18) { p_ln<0, true>(F, XFB, nullptr, F.in[13] + 3 * D, F.in[14] + 3 * D, XB); }
    SEAM(18);
    MOE_LAYER(1, 19, XFB, XFA, true)
#undef IN
#undef SEAM
}

extern "C" void kernel_launch(void* const* d_in, const int* in_sizes, int n_in, void* d_out, int out_size, void* d_ws, size_t ws_size, hipStream_t stream) {
    static int grid = 0;
    if (grid == 0) {
        if (n_in != 26 || out_size != NTOK * D || ws_size < WS_END) { fprintf(stderr, "kernel_launch: unexpected problem (n_in %d out %d ws %zu need %zu)\n", n_in, out_size, ws_size, (size_t)WS_END); grid = -1; return; }
        int dev = 0, cus = 0, per_cu = 0;
        if (hipGetDevice(&dev) != hipSuccess || hipDeviceGetAttribute(&cus, hipDeviceAttributeMultiprocessorCount, dev) != hipSuccess) { grid = -1; return; }
        if (hipFuncSetAttribute((const void*)fwd, hipFuncAttributeMaxDynamicSharedMemorySize, LDS_BYTES) != hipSuccess) { fprintf(stderr, "kernel_launch: hipFuncSetAttribute failed\n"); grid = -1; return; }
        if (hipOccupancyMaxActiveBlocksPerMultiprocessor(&per_cu, (const void*)fwd, NTHREADS, LDS_BYTES) != hipSuccess || per_cu < 1) fprintf(stderr, "kernel_launch: occupancy query reports %d\n", per_cu);
        (void)hipGetLastError();
        grid = cus;
    }
    if (grid < 0) return;
    if (hipMemsetAsync((char*)d_ws + WS_CTL, 0, CTL_ZERO_BYTES, stream) != hipSuccess) return;
    Args a{};
    for (int i = 0; i < 26; ++i) a.in[i] = (const float*)d_in[i];
    a.out = (float*)d_out; a.ws = (unsigned char*)d_ws;
#if MK_PER_PHASE
    for (int ph = 0; ph < 26; ++ph) { a.ph_lo = ph; a.ph_hi = ph + 1; hipLaunchKernelGGL(fwd, dim3(grid), dim3(NTHREADS), LDS_BYTES, stream, a); }
#else
    a.ph_lo = 0; a.ph_hi = 26;
    hipLaunchKernelGGL(fwd, dim3(grid), dim3(NTHREADS), LDS_BYTES, stream, a);
#endif
}
```
